# Optimizing an MI355X kernel written in HIP

```python
import jax, jax.numpy as jnp
from jax import lax
import numpy as np

D_MODEL = 2048
BATCH = 4
SEQ = 4096
DEPTH = 2

CHUNK = 64
QBLK = 128
N_A_LAYERS = DEPTH // 2
N_B_LAYERS = DEPTH - N_A_LAYERS
PLE_DIM = 256
A_HEADS = 16
Q_LORA = 512
KV_LORA = 512
QK_NOPE = 128
QK_ROPE = 64
V_HEAD = 128
QK_HEAD = QK_NOPE + QK_ROPE
ROPE_BASE = 10000.0
B_HEADS = 16
B_HEAD_DIM = D_MODEL // B_HEADS
N_PREV_CHUNKS = 8
REL_CLIP = 256
D_FF = ((8 * D_MODEL + 3 * 256 - 1) // (3 * 256)) * 256
EPS = 1e-6
NEG_INF = -1e30

kernel_name = 'yoco_mla_chunkband_hybrid'


def rmsnorm(x, g):
    xf = x.astype(jnp.float32)
    y = xf * lax.rsqrt(jnp.mean(xf * xf, axis=-1, keepdims=True) + EPS) * g.astype(jnp.float32)
    return y.astype(x.dtype)


def rope_tables(positions):
    inv_freq = ROPE_BASE ** (-jnp.arange(0, QK_ROPE, 2, dtype=jnp.float32) / QK_ROPE)
    ang = positions.astype(jnp.float32)[..., None] * inv_freq
    return jnp.cos(ang)[:, :, None, :], jnp.sin(ang)[:, :, None, :]


def apply_rope(x, cos, sin):
    xf = x.astype(jnp.float32)
    x1, x2 = xf[..., : QK_ROPE // 2], xf[..., QK_ROPE // 2:]
    return jnp.concatenate([x1 * cos - x2 * sin, x2 * cos + x1 * sin], axis=-1).astype(x.dtype)


def block_causal_attention(q, k, v):
    B, S, H, Dq = q.shape
    Dv = v.shape[-1]
    scale = 1.0 / np.sqrt(Dq)
    key_chunk = jnp.arange(S) // CHUNK

    def one_block(b):
        start = b * QBLK
        qb = lax.dynamic_slice_in_dim(q, start, QBLK, axis=1)
        q_chunk = (start + jnp.arange(QBLK)) // CHUNK
        s = jnp.einsum('bqhd,bkhd->bhqk', qb, k).astype(jnp.float32) * scale
        s = jnp.where(key_chunk[None, :] <= q_chunk[:, None], s, NEG_INF)
        pr = jax.nn.softmax(s, axis=-1).astype(v.dtype)
        return jnp.einsum('bhqk,bkhd->bqhd', pr, v)

    out = lax.map(one_block, jnp.arange(S // QBLK))
    return out.transpose(1, 0, 2, 3, 4).reshape(B, S, H, Dv)


def mla_mixer(h, positions, w_dq, g_q, w_uq, w_dkv, g_kv, w_ukv, g_qn, g_kn, w_o):
    B, S, _ = h.shape
    cq = rmsnorm(h @ w_dq, g_q)
    q = (cq @ w_uq).reshape(B, S, A_HEADS, QK_HEAD)
    ckv = h @ w_dkv
    c_kv = rmsnorm(ckv[..., :KV_LORA], g_kv)
    k_pe = ckv[..., KV_LORA:][:, :, None, :]
    kv = (c_kv @ w_ukv).reshape(B, S, A_HEADS, QK_NOPE + V_HEAD)
    k_nope, v = kv[..., :QK_NOPE], kv[..., QK_NOPE:]
    k = jnp.concatenate([k_nope, jnp.broadcast_to(k_pe, (B, S, A_HEADS, QK_ROPE))], axis=-1)
    q = rmsnorm(q, g_qn)
    k = rmsnorm(k, g_kn)
    cos, sin = rope_tables(positions)
    q = jnp.concatenate([q[..., :QK_NOPE], apply_rope(q[..., QK_NOPE:], cos, sin)], axis=-1)
    k = jnp.concatenate([k[..., :QK_NOPE], apply_rope(k[..., QK_NOPE:], cos, sin)], axis=-1)
    o = block_causal_attention(q, k, v)
    return o.reshape(B, S, A_HEADS * V_HEAD) @ w_o


def chunk_band_attention(q, k, v, positions, rel_table):
    B, S, H, Dh = q.shape
    band = (N_PREV_CHUNKS + 1) * CHUNK
    pad = N_PREV_CHUNKS * CHUNK
    scale = 1.0 / np.sqrt(Dh)
    kp = jnp.pad(k, ((0, 0), (pad, 0), (0, 0), (0, 0)))
    vp = jnp.pad(v, ((0, 0), (pad, 0), (0, 0), (0, 0)))
    pos_p = jnp.pad(positions, ((0, 0), (pad, 0)))
    valid_p = jnp.arange(S + pad) >= pad

    def one_chunk(c):
        start = c * CHUNK
        qc = lax.dynamic_slice_in_dim(q, start, CHUNK, axis=1)
        kb = lax.dynamic_slice_in_dim(kp, start, band, axis=1)
        vb = lax.dynamic_slice_in_dim(vp, start, band, axis=1)
        qpos = lax.dynamic_slice_in_dim(positions, start, CHUNK, axis=1)
        kpos = lax.dynamic_slice_in_dim(pos_p, start, band, axis=1)
        vld = lax.dynamic_slice_in_dim(valid_p, start, band, axis=0)
        rel = jnp.clip(qpos[:, :, None] - kpos[:, None, :], -REL_CLIP, REL_CLIP) + REL_CLIP
        bias = rel_table[:, rel].transpose(1, 0, 2, 3)
        s = jnp.einsum('bqhd,bkhd->bhqk', qc, kb).astype(jnp.float32) * scale + bias.astype(jnp.float32)
        s = jnp.where(vld[None, None, None, :], s, NEG_INF)
        pr = jax.nn.softmax(s, axis=-1).astype(v.dtype)
        return jnp.einsum('bhqk,bkhd->bqhd', pr, vb)

    out = lax.map(one_chunk, jnp.arange(S // CHUNK))
    return out.transpose(1, 0, 2, 3, 4).reshape(B, S, H, Dh)


def swiglu(h, w_gate, w_up, w_down):
    return (jax.nn.silu(h @ w_gate) * (h @ w_up)) @ w_down


def setup_inputs(seed: int = 0) -> dict:
    key = jax.random.key(seed)
    ks = iter(jax.random.split(key, 40))

    def w(shape, fan_in):
        return jax.random.normal(next(ks), shape, jnp.float32) * (fan_in ** -0.5)

    def gain(shape):
        return 1.0 + 0.1 * jax.random.normal(next(ks), shape, jnp.float32)

    NA, NB, L = N_A_LAYERS, N_B_LAYERS, DEPTH
    x = jax.random.normal(next(ks), (BATCH, SEQ, D_MODEL), jnp.float32)
    p = jax.random.normal(next(ks), (DEPTH, BATCH, SEQ, PLE_DIM), jnp.float32)
    offsets = jax.random.randint(next(ks), (BATCH, 1), 0, 1024, dtype=jnp.int32)
    positions = offsets + jnp.arange(SEQ, dtype=jnp.int32)[None, :]
    return {
        'x': x, 'p': p, 'positions': positions,
        'a_norm': gain((NA, D_MODEL)),
        'a_w_dq': w((NA, D_MODEL, Q_LORA), D_MODEL),
        'a_g_q': gain((NA, Q_LORA)),
        'a_w_uq': w((NA, Q_LORA, A_HEADS * QK_HEAD), Q_LORA),
        'a_w_dkv': w((NA, D_MODEL, KV_LORA + QK_ROPE), D_MODEL),
        'a_g_kv': gain((NA, KV_LORA)),
        'a_w_ukv': w((NA, KV_LORA, A_HEADS * (QK_NOPE + V_HEAD)), KV_LORA),
        'a_g_qn': gain((NA, QK_HEAD)),
        'a_g_kn': gain((NA, QK_HEAD)),
        'a_w_o': w((NA, A_HEADS * V_HEAD, D_MODEL), A_HEADS * V_HEAD),
        's_norm': gain((D_MODEL,)),
        's_w_k': w((D_MODEL, B_HEADS * B_HEAD_DIM), D_MODEL),
        's_w_v': w((D_MODEL, B_HEADS * B_HEAD_DIM), D_MODEL),
        's_g_kn': gain((B_HEAD_DIM,)),
        'b_norm': gain((NB, D_MODEL)),
        'b_w_q': w((NB, D_MODEL, B_HEADS * B_HEAD_DIM), D_MODEL),
        'b_g_qn': gain((NB, B_HEAD_DIM)),
        'b_rel_bias': 0.5 * jax.random.normal(next(ks), (NB, B_HEADS, 2 * REL_CLIP + 1), jnp.float32),
        'b_w_o': w((NB, B_HEADS * B_HEAD_DIM, D_MODEL), B_HEADS * B_HEAD_DIM),
        'f_norm': gain((L, D_MODEL)),
        'f_w_gate': w((L, D_MODEL, D_FF), D_MODEL),
        'f_w_up': w((L, D_MODEL, D_FF), D_MODEL),
        'f_w_down': w((L, D_FF, D_MODEL), D_FF),
        'e_norm': gain((L, D_MODEL)),
        'e_w_gate': w((L, D_MODEL, D_MODEL), D_MODEL),
        'e_w_proj': w((L, PLE_DIM, D_MODEL), PLE_DIM),
    }


def reference(x, p, positions,
              a_norm, a_w_dq, a_g_q, a_w_uq, a_w_dkv, a_g_kv, a_w_ukv, a_g_qn, a_g_kn, a_w_o,
              s_norm, s_w_k, s_w_v, s_g_kn,
              b_norm, b_w_q, b_g_qn, b_rel_bias, b_w_o,
              f_norm, f_w_gate, f_w_up, f_w_down,
              e_norm, e_w_gate, e_w_proj):
    B, S, _ = x.shape
    shared_k = None
    shared_v = None
    for i in range(DEPTH):
        if i < N_A_LAYERS:
            j = i
            h = rmsnorm(x, a_norm[j])
            x = x + mla_mixer(h, positions, a_w_dq[j], a_g_q[j], a_w_uq[j], a_w_dkv[j], a_g_kv[j],
                              a_w_ukv[j], a_g_qn[j], a_g_kn[j], a_w_o[j])
        else:
            j = i - N_A_LAYERS
            h = rmsnorm(x, b_norm[j])
            q = rmsnorm((h @ b_w_q[j]).reshape(B, S, B_HEADS, B_HEAD_DIM), b_g_qn[j])
            o = chunk_band_attention(q, shared_k, shared_v, positions, b_rel_bias[j])
            x = x + o.reshape(B, S, B_HEADS * B_HEAD_DIM) @ b_w_o[j]
        x = x + swiglu(rmsnorm(x, f_norm[i]), f_w_gate[i], f_w_up[i], f_w_down[i])
        gate = jax.nn.sigmoid(rmsnorm(x, e_norm[i]) @ e_w_gate[i])
        x = x + gate * (p[i] @ e_w_proj[i])
        if i == N_A_LAYERS - 1:
            hs = rmsnorm(x, s_norm)
            shared_k = rmsnorm((hs @ s_w_k).reshape(B, S, B_HEADS, B_HEAD_DIM), s_g_kn)
            shared_v = (hs @ s_w_v).reshape(B, S, B_HEADS, B_HEAD_DIM)
    return x
```

```cpp
#include <hip/hip_runtime.h>
#include <hip/hip_cooperative_groups.h>
#include <cstdio>
#include <cstdint>
namespace cg = cooperative_groups;

#define LAS __attribute__((address_space(3)))
typedef unsigned short bf16_t;
typedef short bf16x8 __attribute__((ext_vector_type(8)));
typedef float f32x4 __attribute__((ext_vector_type(4)));
typedef float f32x16 __attribute__((ext_vector_type(16)));
typedef unsigned u32x4 __attribute__((ext_vector_type(4)));
typedef unsigned u32x2 __attribute__((ext_vector_type(2)));
typedef short s16x4 __attribute__((ext_vector_type(4)));

constexpr int M = 16384, D = 2048, SEQ = 4096, NB = 4, FF = 5632, NH = 16, PLE = 256;
constexpr int N1P = 1280;
constexpr float EPS = 1e-6f, LOG2E = 1.4426950408889634f;

__device__ __forceinline__ unsigned cvt_pk_bf16(float lo, float hi) { unsigned r; asm volatile("v_cvt_pk_bf16_f32 %0, %1, %2" : "=v"(r) : "v"(lo), "v"(hi)); return r; }
__device__ __forceinline__ float bf2f(unsigned u16) { return __uint_as_float(u16 << 16); }
__device__ __forceinline__ float bflo(unsigned w) { return __uint_as_float(w << 16); }
__device__ __forceinline__ float bfhi(unsigned w) { return __uint_as_float(w & 0xffff0000u); }
__device__ __forceinline__ float wave_sum(float v) {
#pragma unroll
    for (int o = 1; o < 64; o <<= 1) v += __shfl_xor(v, o);
    return v;
}
__device__ __forceinline__ float fsigmoid(float a) { return __builtin_amdgcn_rcpf(1.0f + __builtin_amdgcn_exp2f(-a * LOG2E)); }

namespace pg8 {
constexpr int BM = 256, BK = 64, HALF = 128, HTB = HALF * BK * 2, STAGE_BYTES = 8 * HTB, NXCD = 8, WGM = 8;
__host__ __device__ __forceinline__ int lds_byte(int r, int c) { const int st = (r >> 4) * 2 + (c >> 5), rr = r & 15, cc = c & 31, ob = rr * 64 + cc * 2; return st * 1024 + (ob ^ (((ob >> 9) & 1) << 5)); }
__host__ __device__ __forceinline__ void stage_rc(int b, int& R, int& C) { const int st = b / 1024, sb = b % 1024, swz = sb ^ (((sb >> 9) & 1) << 5); R = (st >> 1) * 16 + swz / 64; C = (st & 1) * 32 + (swz % 64) / 2; }
__host__ __device__ __forceinline__ int perm32(int rho) { const int n = rho >> 4, i = rho & 15; return 8 * (i >> 2) + 4 * n + (i & 3); }

struct Unit { int pm, pn; };
struct Gemm { const bf16_t* A; const bf16_t* Bt; int M, N, K; int lda; size_t kstepA; };

struct StaticOrder {
    int nM, nN, nwg, G, c, wgm, rev;
    __device__ void init(int M_, int N_, int G_, int c_, int rev_ = 0) { nM = M_ / BM; nN = N_ / BM; nwg = nM * nN; G = G_; c = c_; wgm = (nN == 8) ? 4 : WGM; rev = rev_; }
    __device__ bool next(int i, Unit& u) const {
        const long L = (long)i * G + c; if (L >= nwg) return false;
        int wgid = (int)L; { const int q = nwg / NXCD, r = nwg % NXCD, xcd = wgid % NXCD, off = wgid / NXCD; wgid = (xcd < r ? xcd * (q + 1) : r * (q + 1) + (xcd - r) * q) + off; }
        const int nig = wgm * nN, gid = wgid / nig, fm = gid * wgm, gsz = (nM - fm) < wgm ? (nM - fm) : wgm;
        u.pm = fm + ((wgid % nig) % gsz); u.pn = (wgid % nig) / gsz; if (rev) u.pm = nM - 1 - u.pm;
        return true;
    }
};

template <int MODE> struct EpiB {
    static constexpr bool PERM = true;
    bf16_t* O0; bf16_t* O1; int ldc; const float* ss_in;
    __device__ __forceinline__ void operator()(const f32x4 (&acc)[2][2][4][2], const Unit& u, int wr, int wc, int fr, int fq) const {
        const int row0 = u.pm * BM + wr * 64 + fr;
        const int col0 = (MODE == 0 ? u.pn * BM : u.pn * HALF) + wc * 32 + 8 * fq;
        float rsv[2][4];
#pragma unroll
        for (int ai = 0; ai < 2; ++ai)
#pragma unroll
            for (int m = 0; m < 4; ++m) rsv[ai][m] = ss_in ? ss_in[row0 + ai * HALF + m * 16] : 0.f;
#pragma unroll
        for (int ai = 0; ai < 2; ++ai)
#pragma unroll
            for (int m = 0; m < 4; ++m) {
                const size_t roff = (size_t)(row0 + ai * HALF + m * 16) * ldc + col0;
                const float rs = ss_in ? __builtin_amdgcn_rsqf(rsv[ai][m] * (1.0f / D) + EPS) : 1.0f;
                if (MODE == 2) {
                    f32x4 g0 = acc[ai][0][m][0] * rs, g1 = acc[ai][0][m][1] * rs, u0 = acc[ai][1][m][0] * rs, u1 = acc[ai][1][m][1] * rs;
#pragma unroll
                    for (int e = 0; e < 4; ++e) { g0[e] = g0[e] * fsigmoid(g0[e]) * u0[e]; g1[e] = g1[e] * fsigmoid(g1[e]) * u1[e]; }
                    u32x4 w; w.x = cvt_pk_bf16(g0[0], g0[1]); w.y = cvt_pk_bf16(g0[2], g0[3]); w.z = cvt_pk_bf16(g1[0], g1[1]); w.w = cvt_pk_bf16(g1[2], g1[3]);
                    { const int col = col0, row = row0 + ai * HALF + m * 16; *(u32x4*)(O0 + ((size_t)(col >> 6) * M + row) * 64 + (col & 63)) = w; }
                } else {
#pragma unroll
                    for (int bj = 0; bj < 2; ++bj) {
                        const f32x4 v0 = acc[ai][bj][m][0] * rs, v1 = acc[ai][bj][m][1] * rs;
                        u32x4 w; w.x = cvt_pk_bf16(v0[0], v0[1]); w.y = cvt_pk_bf16(v0[2], v0[3]); w.z = cvt_pk_bf16(v1[0], v1[1]); w.w = cvt_pk_bf16(v1[2], v1[3]);
                        if (MODE == 0) *(u32x4*)(O0 + roff + bj * HALF) = w;
                        else *(u32x4*)((bj == 0 ? O0 : O1) + roff) = w;
                    }
                }
            }
    }
};
template <int MODE, int BASE> struct EpiF {
    static constexpr bool PERM = false;
    const float* base; const bf16_t* baseb; float* out; const bf16_t* pp; int ldc;
    bf16_t* xb; float* ss_out;
    const float* ss_in;
    __device__ __forceinline__ void operator()(const f32x4 (&acc)[2][2][4][2], const Unit& u, int wr, int wc, int fr, int fq) const {
        const int row0 = u.pm * BM + wr * 64 + fr, col0 = u.pn * BM + wc * 32 + 4 * fq;
        float rsv[2][4];
        if (MODE == 1) {
#pragma unroll
            for (int ai = 0; ai < 2; ++ai)
#pragma unroll
                for (int m = 0; m < 4; ++m) rsv[ai][m] = ss_in[row0 + ai * HALF + m * 16];
        }
#pragma unroll
        for (int ai = 0; ai < 2; ++ai)
#pragma unroll
            for (int mp = 0; mp < 2; ++mp) {
                f32x4 bv[2][2][2]; u32x2 bw[2][2][2]; u32x2 pv[2][2][2];
#pragma unroll
                for (int mi = 0; mi < 2; ++mi)
#pragma unroll
                    for (int bj = 0; bj < 2; ++bj)
#pragma unroll
                        for (int n = 0; n < 2; ++n) {
                            const size_t c = (size_t)(row0 + ai * HALF + (2 * mp + mi) * 16) * ldc + col0 + bj * HALF + n * 16;
                            if (BASE == 0) bv[mi][bj][n] = *(const f32x4*)(base + c); else bw[mi][bj][n] = *(const u32x2*)(baseb + c);
                            if (MODE == 1) pv[mi][bj][n] = *(const u32x2*)(pp + c);
                        }
#pragma unroll
                for (int mi = 0; mi < 2; ++mi) {
                    const int m = 2 * mp + mi, row = row0 + ai * HALF + m * 16;
                    const size_t roff = (size_t)row * ldc + col0;
                    float rs = 1.0f; if (MODE == 1) rs = __builtin_amdgcn_rsqf(rsv[ai][m] * (1.0f / D) + EPS);
                    float sq = 0.f;
#pragma unroll
                    for (int bj = 0; bj < 2; ++bj)
#pragma unroll
                        for (int n = 0; n < 2; ++n) {
                            const size_t c = roff + bj * HALF + n * 16;
                            f32x4 a = acc[ai][bj][m][n];
                            if (MODE == 1) { const u32x2 p2 = pv[mi][bj][n];
                                a[0] = fsigmoid(a[0] * rs) * bflo(p2.x); a[1] = fsigmoid(a[1] * rs) * bfhi(p2.x); a[2] = fsigmoid(a[2] * rs) * bflo(p2.y); a[3] = fsigmoid(a[3] * rs) * bfhi(p2.y); }
                            f32x4 b;
                            if (BASE == 0) b = bv[mi][bj][n]; else { const u32x2 q = bw[mi][bj][n]; b = (f32x4){bflo(q.x), bfhi(q.x), bflo(q.y), bfhi(q.y)}; }
                            const f32x4 o = b + a;
                            if (out) *(f32x4*)(out + c) = o;
                            if (xb) { u32x2 w; w.x = cvt_pk_bf16(o[0], o[1]); w.y = cvt_pk_bf16(o[2], o[3]); *(u32x2*)(xb + c) = w;
                                const float r0 = bflo(w.x), r1 = bfhi(w.x), r2 = bflo(w.y), r3 = bfhi(w.y); sq += (r0 * r0 + r1 * r1) + (r2 * r2 + r3 * r3); }
                        }
                    if (xb) { sq += __shfl_xor(sq, 16); sq += __shfl_xor(sq, 32); if (fq == 0) atomicAdd(ss_out + row, sq); }
                }
            }
    }
};

template <class Epi, class Sched, bool ALIGN_EPI, bool SP2>
__device__ __forceinline__ void gemm_phase(LAS unsigned char* lds, const Gemm g, const Sched& S, const Epi& E, const int tid) {
    const int wid = __builtin_amdgcn_readfirstlane(tid >> 6), lane = tid & 63, wr = wid >> 2, wc = wid & 3, fr = lane & 15, fq = lane >> 4;
    const int K = g.K, nt = K / BK;
    unsigned voffA[2], voffB[2];
#pragma unroll
    for (int i = 0; i < 2; ++i) { int R, C; stage_rc(tid * 16 + i * 8192, R, C); const int Rb = Epi::PERM ? ((R & ~31) + perm32(R & 31)) : R;
        voffA[i] = (unsigned)(R * g.lda + C) * 2u; voffB[i] = (unsigned)(Rb * 64 + C) * 2u; }
    const size_t kstep = (size_t)(BK * 2);
    const size_t hstepA = (size_t)HALF * g.lda * 2, hstepB = (size_t)HALF * 64 * 2;
    const size_t tstepA = 2 * hstepA, tstepB = 2 * hstepB;
    const size_t kstepA = g.kstepA, kstepB = (size_t)g.N * 128;
    const unsigned ldsw = (unsigned)wid * 1024u;
    const int aoff = lds_byte(wr * 64 + fr, fq * 8), boff = lds_byte(wc * 32 + fr, fq * 8);
#define PG8_SA(b, h) (((b) * 2 + (h)) * HTB)
#define PG8_SB(b, h) ((4 + (b) * 2 + (h)) * HTB)
#define PG8_STAGE(bufoff, gbase, voff) do { _Pragma("unroll") for (int _i = 0; _i < 2; ++_i) \
        __builtin_amdgcn_global_load_lds((const unsigned*)((const char*)(gbase) + (voff)[_i]), (LAS unsigned*)(lds + (bufoff) + ldsw + _i * 8192), 16, 0, 0); } while (0)
#define PG8_LDA(dst, b, h) do { _Pragma("unroll") for (int m = 0; m < 4; ++m) _Pragma("unroll") for (int k = 0; k < 2; ++k) dst[m][k] = *(const LAS bf16x8*)(lds + PG8_SA(b, h) + aoff + m * 2048 + k * 1024); } while (0)
#define PG8_LDB(dst, b, h) do { _Pragma("unroll") for (int n = 0; n < 2; ++n) _Pragma("unroll") for (int k = 0; k < 2; ++k) dst[n][k] = *(const LAS bf16x8*)(lds + PG8_SB(b, h) + boff + n * 2048 + k * 1024); } while (0)
#define PG8_MMA(ai, bj, At, Bt) do { __builtin_amdgcn_s_setprio(1); _Pragma("unroll") for (int m = 0; m < 4; ++m) _Pragma("unroll") for (int n = 0; n < 2; ++n) _Pragma("unroll") for (int k = 0; k < 2; ++k) \
        acc[ai][bj][m][n] = __builtin_amdgcn_mfma_f32_16x16x32_bf16(Bt[n][k], At[m][k], acc[ai][bj][m][n], 0, 0, 0); __builtin_amdgcn_s_setprio(0); } while (0)
#define PG8_WAIT_V(n) asm volatile("s_waitcnt vmcnt(" #n ")" ::: "memory")
#define PG8_WAIT_L(n) asm volatile("s_waitcnt lgkmcnt(" #n ")" ::: "memory")
#define PG8_BAR __builtin_amdgcn_s_barrier()
#define PG8_SCHED __builtin_amdgcn_sched_barrier(0)
    Unit cur, nxt; int ui = 0;
    if (!S.next(0, cur)) return;
    f32x4 acc[2][2][4][2];
#pragma unroll
    for (int a = 0; a < 2; ++a)
#pragma unroll
        for (int b = 0; b < 2; ++b)
#pragma unroll
            for (int m = 0; m < 4; ++m)
#pragma unroll
                for (int n = 0; n < 2; ++n) acc[a][b][m][n] = (f32x4){0.f, 0.f, 0.f, 0.f};
    bf16x8 At[4][2], B0[2][2], B1[2][2];
    const char* cA = (const char*)g.A + (size_t)cur.pm * tstepA; const char* cB = (const char*)g.Bt + (size_t)cur.pn * tstepB;
    if constexpr (SP2) {
        PG8_STAGE(PG8_SB(0, 0), cB, voffB); PG8_STAGE(PG8_SB(0, 1), cB + hstepB, voffB); PG8_STAGE(PG8_SA(0, 0), cA, voffA); PG8_STAGE(PG8_SA(0, 1), cA + hstepA, voffA);
        if (wr == 1) PG8_BAR;
        PG8_WAIT_V(2); PG8_BAR;
        PG8_STAGE(PG8_SB(1, 0), cB + kstepB, voffB); PG8_STAGE(PG8_SA(1, 0), cA + kstepA, voffA); PG8_STAGE(PG8_SB(1, 1), cB + hstepB + kstepB, voffB);
        PG8_WAIT_V(6); PG8_BAR;
    } else {
        PG8_STAGE(PG8_SB(0, 0), cB, voffB); PG8_STAGE(PG8_SA(0, 0), cA, voffA); PG8_STAGE(PG8_SB(0, 1), cB + hstepB, voffB); PG8_STAGE(PG8_SA(0, 1), cA + hstepA, voffA);
        if (wr == 1) PG8_BAR;
        PG8_WAIT_V(4); PG8_BAR;
        PG8_STAGE(PG8_SB(1, 0), cB + kstepB, voffB); PG8_STAGE(PG8_SA(1, 0), cA + kstepA, voffA); PG8_STAGE(PG8_SB(1, 1), cB + hstepB + kstepB, voffB);
        PG8_WAIT_V(6); PG8_BAR;
    }
    for (;;) {
        const bool has_next = S.next(ui + 1, nxt);
        const char* nA = has_next ? (const char*)g.A + (size_t)nxt.pm * tstepA : cA; const char* nB = has_next ? (const char*)g.Bt + (size_t)nxt.pn * tstepB : cB;
        for (int t = 0; t < nt; t += 2) {
            const bool last = (t == nt - 2);
            const char* a1 = cA + (size_t)(t + 1) * kstepA;
            const char* a2 = last ? nA : cA + (size_t)(t + 2) * kstepA; const char* b2 = last ? nB : cB + (size_t)(t + 2) * kstepB;
            const char* a3 = a2 + kstepA; const char* b3 = b2 + kstepB;
            if constexpr (SP2) {
            PG8_LDB(B0, 0, 0); PG8_LDB(B1, 0, 1); PG8_SCHED; PG8_LDA(At, 0, 0); PG8_STAGE(PG8_SA(1, 1), a1 + hstepA, voffA);
            PG8_WAIT_V(8); PG8_WAIT_L(0); PG8_BAR; PG8_MMA(0, 0, At, B0); PG8_MMA(0, 1, At, B1); PG8_BAR; PG8_SCHED;
            PG8_LDA(At, 0, 1); PG8_STAGE(PG8_SB(0, 0), b2, voffB); PG8_STAGE(PG8_SB(0, 1), b2 + hstepB, voffB); PG8_STAGE(PG8_SA(0, 0), a2, voffA);
            PG8_WAIT_V(8); PG8_WAIT_L(0); PG8_BAR; PG8_MMA(1, 0, At, B0); PG8_MMA(1, 1, At, B1); PG8_BAR; PG8_SCHED;
            PG8_LDB(B0, 1, 0); PG8_LDB(B1, 1, 1); PG8_SCHED; PG8_LDA(At, 1, 0); PG8_STAGE(PG8_SA(0, 1), a2 + hstepA, voffA);
            PG8_WAIT_V(8); PG8_WAIT_L(0); PG8_BAR; PG8_MMA(0, 0, At, B0); PG8_MMA(0, 1, At, B1); PG8_BAR; PG8_SCHED;
            PG8_LDA(At, 1, 1); PG8_STAGE(PG8_SB(1, 0), b3, voffB); PG8_STAGE(PG8_SB(1, 1), b3 + hstepB, voffB); PG8_STAGE(PG8_SA(1, 0), a3, voffA);
            PG8_WAIT_V(8); PG8_WAIT_L(0); PG8_BAR; PG8_MMA(1, 0, At, B0); PG8_MMA(1, 1, At, B1); PG8_BAR; PG8_SCHED;
            } else {
            PG8_LDB(B0, 0, 0); PG8_SCHED; PG8_LDA(At, 0, 0); PG8_STAGE(PG8_SA(1, 1), a1 + hstepA, voffA);
            PG8_WAIT_L(8); PG8_BAR; PG8_WAIT_L(0); PG8_MMA(0, 0, At, B0); PG8_BAR; PG8_SCHED;
            PG8_LDB(B1, 0, 1); PG8_STAGE(PG8_SB(0, 0), b2, voffB);
            PG8_BAR; PG8_WAIT_L(0); PG8_MMA(0, 1, At, B1); PG8_BAR;
            PG8_LDA(At, 0, 1); PG8_STAGE(PG8_SA(0, 0), a2, voffA);
            PG8_BAR; PG8_WAIT_L(0); PG8_MMA(1, 0, At, B0); PG8_BAR; PG8_SCHED;
            PG8_STAGE(PG8_SB(0, 1), b2 + hstepB, voffB);
            PG8_WAIT_V(6); PG8_BAR; PG8_MMA(1, 1, At, B1); PG8_BAR;
            PG8_LDB(B0, 1, 0); PG8_SCHED; PG8_LDA(At, 1, 0); PG8_STAGE(PG8_SA(0, 1), a2 + hstepA, voffA);
            PG8_WAIT_L(8); PG8_BAR; PG8_WAIT_L(0); PG8_MMA(0, 0, At, B0); PG8_BAR; PG8_SCHED;
            PG8_LDB(B1, 1, 1); PG8_STAGE(PG8_SB(1, 0), b3, voffB);
            PG8_BAR; PG8_WAIT_L(0); PG8_MMA(0, 1, At, B1); PG8_BAR;
            PG8_LDA(At, 1, 1); PG8_STAGE(PG8_SA(1, 0), a3, voffA);
            PG8_BAR; PG8_WAIT_L(0); PG8_MMA(1, 0, At, B0); PG8_BAR; PG8_SCHED;
            PG8_STAGE(PG8_SB(1, 1), b3 + hstepB, voffB);
            PG8_WAIT_V(6); PG8_BAR; PG8_MMA(1, 1, At, B1); PG8_BAR;
            }
        }
        if constexpr (ALIGN_EPI) { if (wr == 0) PG8_BAR; }
        E(acc, cur, wr, wc, fr, fq);
        if (!has_next) break;
#pragma unroll
        for (int a = 0; a < 2; ++a)
#pragma unroll
            for (int b = 0; b < 2; ++b)
#pragma unroll
                for (int m = 0; m < 4; ++m)
#pragma unroll
                    for (int n = 0; n < 2; ++n) acc[a][b][m][n] = (f32x4){0.f, 0.f, 0.f, 0.f};
        cur = nxt; cA = nA; cB = nB; ++ui;
        if constexpr (ALIGN_EPI) { if (wr == 1) PG8_BAR; }
    }
    PG8_WAIT_V(0);
    if constexpr (!ALIGN_EPI) { if (wr == 0) PG8_BAR; }
    PG8_BAR;
#undef PG8_SA
#undef PG8_SB
#undef PG8_STAGE
#undef PG8_LDA
#undef PG8_LDB
#undef PG8_MMA
#undef PG8_WAIT_V
#undef PG8_WAIT_L
#undef PG8_BAR
#undef PG8_SCHED
}
}

struct AttnP { const bf16_t* Q; int ldq, hsq; const bf16_t* K; int ldk, hsk; const bf16_t* V; int ldv, hsv; bf16_t* O; int ldo; const float* bias; const int* pos; const float* gq; const float* cs; const float* sn; };
__device__ __forceinline__ int crow(int r, int hi) { return (r & 3) + 8 * (r >> 2) + 4 * hi; }

template <int DQK, bool BAND>
__device__ __forceinline__ void attn_phase(LAS unsigned char* lds, const AttnP P, const int tid) {
    constexpr int SK = DQK * 2 + 16, SV = 320;
    constexpr int KBYTES = 64 * SK, VBYTES = 64 * SV, BUF = KBYTES + VBYTES;
    constexpr int OFF_KPOS = 2 * BUF, OFF_BIAS = OFF_KPOS + 512, OFF_KMAX = OFF_BIAS + 2112;
    constexpr int CPR = DQK / 8, NKC = 64 * CPR / 512, NDS = DQK / 16;
    const int lane = tid & 63, r32 = lane & 31, hi = lane >> 5;
    const int wid = __builtin_amdgcn_readfirstlane(tid >> 6);
    LAS int* kposL = (LAS int*)(lds + OFF_KPOS);
    LAS float* biasL = (LAS float*)(lds + OFF_BIAS);
    LAS int* kmaxL = (LAS int*)(lds + OFF_KMAX);
    constexpr int NUNITS = NB * NH * (SEQ / 256);
    for (int ui = blockIdx.x; ui < NUNITS; ui += gridDim.x) {
        const int jr = ui >> 8, vv = ui & 255, bh = vv >> 2, s4 = vv & 3;
        const int qb = (jr == 0) ? s4 : (jr == 1) ? 7 - s4 : (jr == 2) ? 8 + s4 : 15 - s4;
        const int b = bh / NH, h = bh % NH;
        const size_t rowbase = (size_t)b * SEQ; const int q0 = qb * 256;
        const int cw = 4 * qb + (wid >> 1);
        const int t_lo = BAND ? (4 * qb - 8 > 0 ? 4 * qb - 8 : 0) : 0, t_hi = 4 * qb + 3;
        const int w_lo = BAND ? (cw - 8 > 0 ? cw - 8 : 0) : 0, w_hi = cw;
        bf16x8 qf[NDS];
        { const bf16_t* qp = P.Q + (rowbase + q0 + wid * 32 + r32) * P.ldq + h * P.hsq + hi * 8;
#pragma unroll
          for (int ds = 0; ds < NDS; ++ds) qf[ds] = *(const bf16x8*)(qp + ds * 16); }
        {
            float ssq = 0.f;
#pragma unroll
            for (int ds = 0; ds < NDS; ++ds)
#pragma unroll
                for (int e = 0; e < 8; ++e) { const float v = bf2f((unsigned)(unsigned short)qf[ds][e]); ssq += v * v; }
            ssq += __shfl_xor(ssq, 32);
            const float rq = __builtin_amdgcn_rsqf(ssq * (1.0f / DQK) + EPS) * ((BAND ? 0.08838834764831845f : 0.07216878364870322f) * LOG2E);
            const size_t tok = rowbase + q0 + wid * 32 + r32;
#pragma unroll
            for (int ds = 0; ds < 8; ++ds) {
                const f32x4 g0 = *(const f32x4*)(P.gq + ds * 16 + hi * 8), g1 = *(const f32x4*)(P.gq + ds * 16 + hi * 8 + 4);
                u32x4 w;
                w.x = cvt_pk_bf16(bf2f((unsigned)(unsigned short)qf[ds][0]) * rq * g0[0], bf2f((unsigned)(unsigned short)qf[ds][1]) * rq * g0[1]);
                w.y = cvt_pk_bf16(bf2f((unsigned)(unsigned short)qf[ds][2]) * rq * g0[2], bf2f((unsigned)(unsigned short)qf[ds][3]) * rq * g0[3]);
                w.z = cvt_pk_bf16(bf2f((unsigned)(unsigned short)qf[ds][4]) * rq * g1[0], bf2f((unsigned)(unsigned short)qf[ds][5]) * rq * g1[1]);
                w.w = cvt_pk_bf16(bf2f((unsigned)(unsigned short)qf[ds][6]) * rq * g1[2], bf2f((unsigned)(unsigned short)qf[ds][7]) * rq * g1[3]);
                qf[ds] = __builtin_bit_cast(bf16x8, w);
            }
            if (!BAND)
#pragma unroll
            for (int j = 0; j < 2; ++j) {
                const int i0 = 16 * j + 8 * hi;
                float o1[8], o2[8];
                const f32x4 cA = *(const f32x4*)(P.cs + tok * 32 + i0), cB = *(const f32x4*)(P.cs + tok * 32 + i0 + 4), sA = *(const f32x4*)(P.sn + tok * 32 + i0), sB = *(const f32x4*)(P.sn + tok * 32 + i0 + 4);
                const f32x4 g1A = *(const f32x4*)(P.gq + 128 + i0), g1B = *(const f32x4*)(P.gq + 128 + i0 + 4), g2A = *(const f32x4*)(P.gq + 160 + i0), g2B = *(const f32x4*)(P.gq + 160 + i0 + 4);
#pragma unroll
                for (int e = 0; e < 8; ++e) {
                    const float c = e < 4 ? cA[e & 3] : cB[e & 3], sn_ = e < 4 ? sA[e & 3] : sB[e & 3];
                    const float x1 = bf2f((unsigned)(unsigned short)qf[8 + j][e]) * rq * (e < 4 ? g1A[e & 3] : g1B[e & 3]), x2 = bf2f((unsigned)(unsigned short)qf[10 + j][e]) * rq * (e < 4 ? g2A[e & 3] : g2B[e & 3]);
                    o1[e] = x1 * c - x2 * sn_; o2[e] = x2 * c + x1 * sn_;
                }
                u32x4 w1, w2;
                w1.x = cvt_pk_bf16(o1[0], o1[1]); w1.y = cvt_pk_bf16(o1[2], o1[3]); w1.z = cvt_pk_bf16(o1[4], o1[5]); w1.w = cvt_pk_bf16(o1[6], o1[7]);
                w2.x = cvt_pk_bf16(o2[0], o2[1]); w2.y = cvt_pk_bf16(o2[2], o2[3]); w2.z = cvt_pk_bf16(o2[4], o2[5]); w2.w = cvt_pk_bf16(o2[6], o2[7]);
                qf[8 + j] = __builtin_bit_cast(bf16x8, w1); qf[10 + j] = __builtin_bit_cast(bf16x8, w2);
            }
        }
        int qpos = 0;
        if (BAND) { for (int i = tid; i < 513; i += 512) biasL[i] = P.bias[h * 513 + i] * LOG2E; qpos = P.pos[rowbase + q0 + wid * 32 + r32]; }
        int qmin = qpos;
        if (BAND) {
#pragma unroll
            for (int o = 1; o < 64; o <<= 1) { const int t_ = __shfl_xor(qmin, o); qmin = t_ < qmin ? t_ : qmin; }
        }
        f32x16 o[4];
#pragma unroll
        for (int d = 0; d < 4; ++d)
#pragma unroll
            for (int r = 0; r < 16; ++r) o[d][r] = 0.f;
        float mrun = -1e30f, lrun = 0.f;
        u32x4 kreg[NKC], vreg[2]; int kpreg = 0;
        const bf16_t* Kh = P.K + rowbase * P.ldk + h * P.hsk; const bf16_t* Vh = P.V + rowbase * P.ldv + h * P.hsv;
        unsigned kgo[NKC], klo[NKC], vgo[2], vlo[2];
#pragma unroll
        for (int i = 0; i < NKC; ++i) { const int c = tid + i * 512, row = c / CPR, cc = c % CPR; kgo[i] = (unsigned)(row * P.ldk + cc * 8); klo[i] = (unsigned)(row * SK + cc * 16); }
#pragma unroll
        for (int i = 0; i < 2; ++i) { const int c = tid + i * 512, row = c >> 4, cc = c & 15; vgo[i] = (unsigned)(row * P.ldv + cc * 8); vlo[i] = (unsigned)(KBYTES + row * SV + cc * 16); }
#define ATT_BAR() do { asm volatile("s_waitcnt lgkmcnt(0)" ::: "memory"); __builtin_amdgcn_s_barrier(); asm volatile("" ::: "memory"); } while (0)
#define ATT_LOADK(t) do { const bf16_t* kt_ = Kh + (size_t)(t) * 64 * P.ldk; _Pragma("unroll") for (int i = 0; i < NKC; ++i) kreg[i] = *(const u32x4*)(kt_ + kgo[i]); } while (0)
#define ATT_LOADV(t) do { const bf16_t* vt_ = Vh + (size_t)(t) * 64 * P.ldv; _Pragma("unroll") for (int i = 0; i < 2; ++i) vreg[i] = *(const u32x4*)(vt_ + vgo[i]); \
        if (BAND) { if (tid < 64) kpreg = P.pos[rowbase + (t) * 64 + tid]; } } while (0)
#define ATT_STOREK(bufi) do { LAS unsigned char* kb_ = lds + (bufi) * BUF; _Pragma("unroll") for (int i = 0; i < NKC; ++i) *(LAS u32x4*)(kb_ + klo[i]) = kreg[i]; } while (0)
#define ATT_STOREV(bufi) do { LAS unsigned char* kb_ = lds + (bufi) * BUF; _Pragma("unroll") for (int i = 0; i < 2; ++i) *(LAS u32x4*)(kb_ + vlo[i]) = vreg[i]; \
        if (BAND) { if (tid < 64) { kposL[(bufi) * 64 + tid] = kpreg; int mx_ = kpreg; _Pragma("unroll") for (int o = 1; o < 64; o <<= 1) { const int t_ = __shfl_xor(mx_, o); mx_ = t_ > mx_ ? t_ : mx_; } if (tid == 0) kmaxL[(bufi)] = mx_; } } } while (0)
        ATT_LOADK(t_lo); ATT_LOADV(t_lo); ATT_STOREK(0); ATT_STOREV(0); __syncthreads();
        const int grp = wid >> 2;
        { const int t1 = t_lo < t_hi ? t_lo + 1 : t_hi; ATT_LOADK(t1); ATT_LOADV(t1); }
        if (grp == 1) ATT_BAR();
        for (int t = t_lo; t <= t_hi; ++t) {
            const int cur = (t - t_lo) & 1;
            const int tn = t + 2 < t_hi ? t + 2 : t_hi;
            const bool part = (t >= w_lo && t <= w_hi);
            const LAS unsigned char* Kb = lds + cur * BUF; const LAS unsigned char* Vb = Kb + KBYTES;
            f32x16 p0, p1;
            if (part) {
#pragma unroll
                for (int r = 0; r < 16; ++r) { p0[r] = 0.f; p1[r] = 0.f; }
#pragma unroll
                for (int ds = 0; ds < NDS; ++ds) {
                    const bf16x8 k0 = *(const LAS bf16x8*)(Kb + r32 * SK + ds * 32 + hi * 16);
                    const bf16x8 k1 = *(const LAS bf16x8*)(Kb + (32 + r32) * SK + ds * 32 + hi * 16);
                    p0 = __builtin_amdgcn_mfma_f32_32x32x16_bf16(k0, qf[ds], p0, 0, 0, 0);
                    p1 = __builtin_amdgcn_mfma_f32_32x32x16_bf16(k1, qf[ds], p1, 0, 0, 0);
                    if ((ds & 1) == 1) __builtin_amdgcn_sched_barrier(0);
                }
            }
            ATT_STOREK(cur ^ 1); ATT_LOADK(tn);
            ATT_BAR();
            if (part) {
                if (BAND && qmin - kmaxL[cur] >= 256) {
                    const float bc = biasL[512];
#pragma unroll
                    for (int r = 0; r < 16; ++r) { p0[r] += bc; p1[r] += bc; }
                } else if (BAND) {
#pragma unroll
                    for (int r = 0; r < 16; ++r) { const int key = crow(r, hi);
                        int r0 = qpos - kposL[cur * 64 + key], r1 = qpos - kposL[cur * 64 + 32 + key];
                        r0 = (r0 < -256 ? -256 : (r0 > 256 ? 256 : r0)) + 256; r1 = (r1 < -256 ? -256 : (r1 > 256 ? 256 : r1)) + 256;
                        p0[r] += biasL[r0]; p1[r] += biasL[r1]; }
                }
                float mx = p0[0];
#pragma unroll
                for (int r = 1; r < 16; ++r) mx = fmaxf(mx, p0[r]);
#pragma unroll
                for (int r = 0; r < 16; ++r) mx = fmaxf(mx, p1[r]);
                mx = fmaxf(mx, __shfl_xor(mx, 32));
                if (__any(mx > mrun + 6.0f)) {
                    const float mnew = fmaxf(mrun, mx), alpha = __builtin_amdgcn_exp2f(mrun - mnew); mrun = mnew;
                    lrun *= alpha;
#pragma unroll
                    for (int d = 0; d < 4; ++d)
#pragma unroll
                        for (int r = 0; r < 16; ++r) o[d][r] *= alpha;
                }
                float ls = 0.f;
#pragma unroll
                for (int r = 0; r < 16; ++r) { p0[r] = __builtin_amdgcn_exp2f(p0[r] - mrun); p1[r] = __builtin_amdgcn_exp2f(p1[r] - mrun); ls += p0[r] + p1[r]; }
                lrun += ls;
                const LAS unsigned char* vbase = Vb + (4 * hi + ((lane & 15) >> 2)) * SV + (16 * ((lane >> 4) & 1) + 4 * (lane & 3)) * 2;
#pragma unroll
                for (int kb = 0; kb < 2; ++kb)
#pragma unroll
                    for (int s = 0; s < 2; ++s) {
                        u32x4 pw;
                        if (kb == 0) { pw.x = cvt_pk_bf16(p0[8 * s + 0], p0[8 * s + 1]); pw.y = cvt_pk_bf16(p0[8 * s + 2], p0[8 * s + 3]); pw.z = cvt_pk_bf16(p0[8 * s + 4], p0[8 * s + 5]); pw.w = cvt_pk_bf16(p0[8 * s + 6], p0[8 * s + 7]); }
                        else         { pw.x = cvt_pk_bf16(p1[8 * s + 0], p1[8 * s + 1]); pw.y = cvt_pk_bf16(p1[8 * s + 2], p1[8 * s + 3]); pw.z = cvt_pk_bf16(p1[8 * s + 4], p1[8 * s + 5]); pw.w = cvt_pk_bf16(p1[8 * s + 6], p1[8 * s + 7]); }
                        const bf16x8 pb = __builtin_bit_cast(bf16x8, pw);
#pragma unroll
                        for (int d = 0; d < 4; ++d) {
                            const LAS unsigned char* ap = vbase + (32 * kb + 16 * s) * SV + d * 64;
                            const s16x4 lo = __builtin_bit_cast(s16x4, __builtin_amdgcn_ds_read_tr16_b64_v4i16((LAS s16x4*)ap));
                            const s16x4 h4 = __builtin_bit_cast(s16x4, __builtin_amdgcn_ds_read_tr16_b64_v4i16((LAS s16x4*)(ap + 8 * SV)));
                            const bf16x8 va = (bf16x8){lo[0], lo[1], lo[2], lo[3], h4[0], h4[1], h4[2], h4[3]};
                            o[d] = __builtin_amdgcn_mfma_f32_32x32x16_bf16(va, pb, o[d], 0, 0, 0);
                        }
                        __builtin_amdgcn_sched_barrier(0);
                    }
            }
            ATT_STOREV(cur ^ 1); ATT_LOADV(tn);
            ATT_BAR();
        }
        if (grp == 0) ATT_BAR();
#undef ATT_BAR
#undef ATT_LOADK
#undef ATT_LOADV
#undef ATT_STOREK
#undef ATT_STOREV
        const float ltot = lrun + __shfl_xor(lrun, 32), inv = 1.0f / ltot;
        bf16_t* op = P.O + (rowbase + q0 + wid * 32 + r32) * P.ldo + h * 128 + 4 * hi;
#pragma unroll
        for (int d = 0; d < 4; ++d)
#pragma unroll
            for (int g4 = 0; g4 < 4; ++g4) {
                u32x2 w; w.x = cvt_pk_bf16(o[d][4 * g4 + 0] * inv, o[d][4 * g4 + 1] * inv); w.y = cvt_pk_bf16(o[d][4 * g4 + 2] * inv, o[d][4 * g4 + 3] * inv);
                *(u32x2*)(op + 32 * d + 8 * g4) = w;
            }
    }
}

constexpr size_t MiB = 1u << 20;
constexpr size_t WS_W1 = 1 * MiB, WS_WUQ = 6 * MiB, WS_WUKV = 9 * MiB, WS_WOA = 13 * MiB, WS_WGU0 = 21 * MiB, WS_WGU1 = 65 * MiB, WS_WD0 = 109 * MiB, WS_WD1 = 131 * MiB,
                 WS_WEG0 = 153 * MiB, WS_WEG1 = 161 * MiB, WS_WEP0 = 169 * MiB, WS_WEP1 = 170 * MiB, WS_WSKVQ = 171 * MiB, WS_WOB = 195 * MiB;
constexpr size_t WS_PBF = 203 * MiB;
constexpr size_t WS_A = 219 * MiB;
constexpr size_t WS_PP = 283 * MiB;
constexpr size_t WS_RAW1 = 347 * MiB;
constexpr size_t WS_KA = 387 * MiB;
constexpr size_t WS_CQN = 387 * MiB, WS_CKVN = 403 * MiB;
constexpr size_t WS_H = 347 * MiB;
constexpr size_t WS_RAW3 = 219 * MiB;
constexpr size_t WS_AB = 475 * MiB;
constexpr size_t WS_OB = 411 * MiB;
constexpr size_t WS_SS = 65536;
constexpr size_t WS_ROPE = 500 * MiB;
constexpr size_t WS_END = 539 * MiB;
constexpr int LDS_BYTES = 135168;
constexpr int NPHASE = 22;
constexpr int REP_P0 = 1, REP_P5 = 1, REP_P7 = 1, REP_P15 = 1, EXTRA_SYNCS = 0;
#define PROBE_DUP8 0
#define PROBE_DUP13 0
#define PROBE_DUP6 0
#define PROBE_DUP1 0
#define PROBE_DUP3 0

#define XB_TMO      128
#define XB_XCNT(j)  (256  + 64 * (j))
#define XB_XSUB(j)  (1280 + 64 * (j))
#define XB_XGEN(j)  (2304 + 64 * (j))
#define XB_TOP      3328
#define XB_TOPGEN   3392
#define XCD_BAR_WORDS 3456
#define XB_SPIN_CAP (1u << 18)

__device__ __forceinline__ unsigned xb_ld(unsigned* p)              { return __hip_atomic_load(p, __ATOMIC_RELAXED, __HIP_MEMORY_SCOPE_AGENT); }
__device__ __forceinline__ unsigned xb_add(unsigned* p, unsigned v) { return __hip_atomic_fetch_add(p, v, __ATOMIC_RELAXED, __HIP_MEMORY_SCOPE_AGENT); }
__device__ __forceinline__ unsigned xb_xcc_id() { return (unsigned)__builtin_amdgcn_s_getreg((3 << 11) | 20) & 0xFu; }
#define XB_SPIN(cond, bar) do { unsigned _sp = 0; while (cond) { __builtin_amdgcn_s_sleep(1); \
    if ((++_sp & 255u) == 0u) { if (xb_ld(&(bar)[XB_TMO])) break; if (_sp > XB_SPIN_CAP) { atomicAdd(&(bar)[XB_TMO], 1u); break; } } } } while (0)

struct XcdBarrier {
    unsigned* bar; unsigned x;
    volatile LAS unsigned* st;
};

__device__ __forceinline__ XcdBarrier xcd_barrier_post(unsigned* bar, volatile LAS unsigned* st) {
    XcdBarrier b; b.bar = bar; b.x = xb_xcc_id(); b.st = st;
    if (threadIdx.x == 0) (void)xb_add(&bar[XB_XCNT(b.x)], 1u);
    return b;
}
__device__ __forceinline__ void xcd_barrier_complete(unsigned* bar, unsigned x, unsigned& nloc, unsigned& nx) {
    const unsigned G = gridDim.x * gridDim.y * gridDim.z;
    unsigned sum, cnt, mine, sp = 0u;
    for (;;) {
        sum = 0u; cnt = 0u; mine = 0u;
#pragma unroll
        for (unsigned j = 0; j < 16; ++j) { const unsigned c = xb_ld(&bar[XB_XCNT(j)]); sum += c; cnt += (c > 0u) ? 1u : 0u; mine = (j == x) ? c : mine; }
        if (sum == G) break;
        __builtin_amdgcn_s_sleep(1);
        if ((++sp & 255u) == 0u) { if (xb_ld(&bar[XB_TMO])) break; if (sp > XB_SPIN_CAP) { atomicAdd(&bar[XB_TMO], 1u); break; } }
    }
    nloc = mine > 0u ? mine : 1u; nx = cnt > 0u ? cnt : 1u;
}

__device__ __forceinline__ void xcd_barrier(const XcdBarrier& b) {
    asm volatile("s_waitcnt vmcnt(0)" ::: "memory");
    __syncthreads();
    if (threadIdx.x == 0) {
        unsigned* bar = b.bar;
        __builtin_amdgcn_s_waitcnt(0);
        unsigned nloc = b.st[0], nx = b.st[1];
        if (nloc == 0u) { xcd_barrier_complete(bar, b.x, nloc, nx); b.st[0] = nloc; b.st[1] = nx; }
        const unsigned old = xb_add(&bar[XB_XSUB(b.x)], 1u);
        const unsigned gen = old / nloc;
        if (old + 1u == (gen + 1u) * nloc) {
            __builtin_amdgcn_fence(__ATOMIC_RELEASE, "agent");
            asm volatile("s_waitcnt vmcnt(0)" ::: "memory");
            const unsigned og = xb_add(&bar[XB_TOP], 1u);
            const unsigned tg = og / nx;
            if (og + 1u == (tg + 1u) * nx) xb_add(&bar[XB_TOPGEN], 1u);
            else XB_SPIN(xb_ld(&bar[XB_TOPGEN]) == tg, bar);
            __builtin_amdgcn_fence(__ATOMIC_ACQUIRE, "agent");
            xb_add(&bar[XB_XGEN(b.x)], 1u);
            asm volatile("s_waitcnt vmcnt(0)" ::: "memory");
        } else {
            XB_SPIN(xb_ld(&bar[XB_XGEN(b.x)]) == gen, bar);
            __builtin_amdgcn_fence(__ATOMIC_ACQUIRE, "agent");
            asm volatile("s_waitcnt vmcnt(0)" ::: "memory");
        }
    }
    __syncthreads();
}


constexpr size_t WS_BAR = 16384;
constexpr int LDS_MISC = 131072 + 64;

struct Args { const void* in[29]; float* out; unsigned char* ws; int ph_lo, ph_hi; };

__device__ __forceinline__ void tr_item(const float* W, int N, const float* g, bf16_t* WT, int ldk, int drow, int k0, int n0, LAS float* scr, int lane) {
    float v[32];
    const float* wp = W + (size_t)(k0 + (lane >> 5)) * N + n0 + (lane & 31);
#pragma unroll
    for (int i = 0; i < 32; ++i) v[i] = __builtin_nontemporal_load(wp + (size_t)(2 * i) * N);
    if (g) {
#pragma unroll
        for (int i = 0; i < 32; ++i) v[i] *= g[k0 + 2 * i + (lane >> 5)];
    }
#pragma unroll
    for (int i = 0; i < 32; ++i) scr[(2 * i + (lane >> 5)) * 33 + (lane & 31)] = v[i];
    asm volatile("s_waitcnt lgkmcnt(0)" ::: "memory");
    const int c = lane & 7;
#pragma unroll
    for (int j = 0; j < 4; ++j) { const int n = (lane >> 3) + 8 * j; const LAS float* s = scr + (8 * c) * 33 + n;
        u32x4 o; o.x = cvt_pk_bf16(s[0 * 33], s[1 * 33]); o.y = cvt_pk_bf16(s[2 * 33], s[3 * 33]); o.z = cvt_pk_bf16(s[4 * 33], s[5 * 33]); o.w = cvt_pk_bf16(s[6 * 33], s[7 * 33]);
        *(u32x4*)(WT + ((size_t)(k0 >> 6) * ldk + drow + n) * 64 + 8 * c) = o; }
    asm volatile("s_waitcnt lgkmcnt(0)" ::: "memory");
}
template <int KIND>
__device__ __forceinline__ void conv_matrix(const float* W, int K, int N, const float* g, bf16_t* WT, int NR, int row_off, int gw, int NGW, LAS float* scr, int lane) {
    const int nblk = N / 32, nitems = (K / 64) * nblk;
    for (int it = gw; it < nitems; it += NGW) { const int kb = it / nblk, nb = it % nblk, n0 = 32 * nb;
        const int drow = KIND == 0 ? row_off + n0 : ((n0 >> 7) * 256 + row_off * 128 + (n0 & 127));
        tr_item(W, N, g, WT, NR, drow, 64 * kb, n0, scr, lane); }
}
__device__ __forceinline__ void rms_row(const float* xrow, bf16_t* orow, int lane) {
    const f32x4* xr = (const f32x4*)xrow + lane;
    f32x4 v[8]; float s = 0.f;
#pragma unroll
    for (int j = 0; j < 8; ++j) { v[j] = xr[64 * j]; s += (v[j].x * v[j].x + v[j].y * v[j].y) + (v[j].z * v[j].z + v[j].w * v[j].w); }
    const float rstd = __builtin_amdgcn_rsqf(wave_sum(s) * (1.0f / D) + EPS);
    u32x2* o8 = (u32x2*)orow + lane;
#pragma unroll
    for (int j = 0; j < 8; ++j) { u32x2 w; w.x = cvt_pk_bf16(v[j].x * rstd, v[j].y * rstd); w.y = cvt_pk_bf16(v[j].z * rstd, v[j].w * rstd); o8[64 * j] = w; }
}

#define PH_BEGIN(k) if (ph_lo <= (k) && (k) < ph_hi) { \
        int tid = wave_s * 64 + (int)__builtin_amdgcn_mbcnt_hi(~0u, __builtin_amdgcn_mbcnt_lo(~0u, 0u)); asm volatile("" : "+v"(tid)); \
        const __attribute__((address_space(4))) Args* ap = (const __attribute__((address_space(4))) Args*)__builtin_amdgcn_kernarg_segment_ptr(); asm volatile("" : "+s"(ap)); \
        const int lane = tid & 63, wave = __builtin_amdgcn_readfirstlane(tid >> 6), gw = blockIdx.x * 8 + wave, NGW = G * 8; \
        unsigned char* ws = ap->ws; float* out = ap->out; \
        const float* x = (const float*)ap->in[0]; const float* pin = (const float*)ap->in[1]; const int* positions = (const int*)ap->in[2]; \
        bf16_t* A = (bf16_t*)(ws + WS_A); bf16_t* PP = (bf16_t*)(ws + WS_PP); bf16_t* PBF = (bf16_t*)(ws + WS_PBF); \
        bf16_t* RAW1 = (bf16_t*)(ws + WS_RAW1); bf16_t* KA = (bf16_t*)(ws + WS_KA); bf16_t* CQN = (bf16_t*)(ws + WS_CQN); bf16_t* CKVN = (bf16_t*)(ws + WS_CKVN); \
        bf16_t* HB = (bf16_t*)(ws + WS_H); bf16_t* RAW3 = (bf16_t*)(ws + WS_RAW3); \
        bf16_t* QA = (bf16_t*)out; bf16_t* VA = A; bf16_t* KN = PP; bf16_t* OA = PP; bf16_t* OB = (bf16_t*)(ws + WS_OB); bf16_t* AB = (bf16_t*)(ws + WS_AB); float* SS = (float*)(ws + WS_SS); \
        (void)lane; (void)wave; (void)gw; (void)NGW; (void)x; (void)pin; (void)positions; (void)PBF; (void)RAW1; (void)KA; (void)CQN; (void)CKVN; (void)HB; (void)RAW3; (void)QA; (void)VA; (void)KN; (void)OA; (void)OB; (void)AB; (void)SS;
#define PH_END(k) if ((k) + 1 < ph_hi) { if (ph_hi > NPHASE) grid.sync(); else xcd_barrier(xbar); } }
#define GEMM_B(MODE, Aptr, Bptr, Nv, Kv, O0v, O1v, ldcv, ssin) do { pg8::Gemm g{Aptr, (const bf16_t*)(Bptr), M, Nv, Kv, Kv, (size_t)128}; pg8::StaticOrder So; So.init(M, Nv, G, (int)blockIdx.x); \
        pg8::EpiB<MODE> E{O0v, O1v, ldcv, ssin}; pg8::gemm_phase<pg8::EpiB<MODE>, pg8::StaticOrder, true, true>(lds, g, So, E, tid); } while (0)
#define GEMM_BX(MODE, ALIGN, Aptr, Bptr, Nv, Kv, O0v, O1v, ldcv, ssin) do { pg8::Gemm g{Aptr, (const bf16_t*)(Bptr), M, Nv, Kv, Kv, (size_t)128}; pg8::StaticOrder So; So.init(M, Nv, G, (int)blockIdx.x); \
        pg8::EpiB<MODE> E{O0v, O1v, ldcv, ssin}; pg8::gemm_phase<pg8::EpiB<MODE>, pg8::StaticOrder, ALIGN, true>(lds, g, So, E, tid); } while (0)
#define GEMM_R(MODE, BASE, Aptr, Bptr, Kv, basefv, basebv, outv, ppv, xbv, ssoutv, ssinv, ldav, kstepv, revv) do { pg8::Gemm g{Aptr, (const bf16_t*)(Bptr), M, D, Kv, ldav, kstepv}; pg8::StaticOrder So; So.init(M, D, G, (int)blockIdx.x, revv); \
        pg8::EpiF<MODE, BASE> E{basefv, basebv, outv, ppv, D, xbv, ssoutv, ssinv}; pg8::gemm_phase<pg8::EpiF<MODE, BASE>, pg8::StaticOrder, true, true>(lds, g, So, E, tid); } while (0)
#define NORM_PASS() do { for (int m = gw; m < M; m += NGW) rms_row(out + (size_t)m * D, A + (size_t)m * D, lane); } while (0)

__global__ void __launch_bounds__(512, 2) yoco_fwd(Args args) {
    extern __shared__ __attribute__((aligned(16))) unsigned char lds_raw[];
    LAS unsigned char* lds = (LAS unsigned char*)lds_raw;
    cg::grid_group grid = cg::this_grid();
    const int G = gridDim.x, ph_lo = args.ph_lo, ph_hi = args.ph_hi;
    const int wave_s = __builtin_amdgcn_readfirstlane(threadIdx.x >> 6);
    if (threadIdx.x < 2) ((volatile LAS unsigned*)(lds + LDS_MISC))[threadIdx.x] = 0u;
    __syncthreads();
    XcdBarrier xbar = xcd_barrier_post((unsigned*)(args.ws + WS_BAR), (volatile LAS unsigned*)(lds + LDS_MISC));

    PH_BEGIN(0)
        for (int i = blockIdx.x * 512 + tid; i < 5 * M; i += G * 512) SS[i] = 0.f;
        for (int rep = 0; rep < REP_P0; ++rep) { if (rep) grid.sync();
            LAS float* scr = (LAS float*)(lds + wave * 16384);
            const float* a_norm = (const float*)ap->in[3];
            conv_matrix<0>((const float*)ap->in[4], D, 512, a_norm, (bf16_t*)(ws + WS_W1), N1P, 0, gw, NGW, scr, lane);
            conv_matrix<0>((const float*)ap->in[7], D, 576, a_norm, (bf16_t*)(ws + WS_W1), N1P, 512, gw, NGW, scr, lane);
            { const int per = 192 * 64 * 2 / 16, nz = (D / 64) * per; for (int i = blockIdx.x * 512 + tid; i < nz; i += G * 512) { const int kt = i / per, j = i % per; ((u32x4*)((bf16_t*)(ws + WS_W1) + ((size_t)kt * N1P + 1088) * 64))[j] = (u32x4){0u, 0u, 0u, 0u}; } }
            conv_matrix<0>((const float*)ap->in[6], 512, 3072, (const float*)ap->in[5], (bf16_t*)(ws + WS_WUQ), 3072, 0, gw, NGW, scr, lane);
            conv_matrix<0>((const float*)ap->in[9], 512, 4096, (const float*)ap->in[8], (bf16_t*)(ws + WS_WUKV), 4096, 0, gw, NGW, scr, lane);
            conv_matrix<0>((const float*)ap->in[12], D, D, nullptr, (bf16_t*)(ws + WS_WOA), D, 0, gw, NGW, scr, lane);
            conv_matrix<0>((const float*)ap->in[14], D, D, (const float*)ap->in[13], (bf16_t*)(ws + WS_WSKVQ), 6144, 0, gw, NGW, scr, lane);
            conv_matrix<0>((const float*)ap->in[15], D, D, (const float*)ap->in[13], (bf16_t*)(ws + WS_WSKVQ), 6144, 2048, gw, NGW, scr, lane);
            conv_matrix<0>((const float*)ap->in[18], D, D, (const float*)ap->in[17], (bf16_t*)(ws + WS_WSKVQ), 6144, 4096, gw, NGW, scr, lane);
            conv_matrix<0>((const float*)ap->in[21], D, D, nullptr, (bf16_t*)(ws + WS_WOB), D, 0, gw, NGW, scr, lane);
            for (int l = 0; l < 2; ++l) {
                const float* fn = (const float*)ap->in[22] + l * D; const float* en = (const float*)ap->in[26] + l * D;
                bf16_t* wgu = (bf16_t*)(ws + (l ? WS_WGU1 : WS_WGU0));
                if (l == 0 || G <= 64) conv_matrix<1>((const float*)ap->in[23] + (size_t)l * D * FF, D, FF, fn, wgu, 2 * FF, 0, gw, NGW, scr, lane);
                if (l == 0 || G <= 64) conv_matrix<1>((const float*)ap->in[24] + (size_t)l * D * FF, D, FF, fn, wgu, 2 * FF, 1, gw, NGW, scr, lane);
                if (l == 0 || (G & 3) != 0) conv_matrix<0>((const float*)ap->in[25] + (size_t)l * FF * D, FF, D, nullptr, (bf16_t*)(ws + (l ? WS_WD1 : WS_WD0)), D, 0, gw, NGW, scr, lane);
                conv_matrix<0>((const float*)ap->in[27] + (size_t)l * D * D, D, D, en, (bf16_t*)(ws + (l ? WS_WEG1 : WS_WEG0)), D, 0, gw, NGW, scr, lane);
                conv_matrix<0>((const float*)ap->in[28] + (size_t)l * PLE * D, PLE, D, nullptr, (bf16_t*)(ws + (l ? WS_WEP1 : WS_WEP0)), D, 0, gw, NGW, scr, lane);
            }
            if (G <= 64) { const int n4 = 2 * M * PLE / 4; const f32x4* p4 = (const f32x4*)pin; u32x2* o2 = (u32x2*)PBF;
              for (int i = blockIdx.x * 512 + tid; i < n4; i += G * 512) { const f32x4 v = p4[i]; u32x2 w; w.x = cvt_pk_bf16(v.x, v.y); w.y = cvt_pk_bf16(v.z, v.w); o2[i] = w; } }
            for (int m = gw; m < M; m += NGW) rms_row(x + (size_t)m * D, A + (size_t)m * D, lane);
        }
    PH_END(0)
    PH_BEGIN(1) GEMM_B(0, A, ws + WS_W1, N1P, D, RAW1, nullptr, N1P, nullptr);
        if (G > 64 && (int)blockIdx.x >= 64) {
            LAS float* scr = (LAS float*)(lds + wave * 16384);
            const float* fn1 = (const float*)ap->in[22] + D; bf16_t* wgu1 = (bf16_t*)(ws + WS_WGU1);
            const int gw1 = ((int)blockIdx.x - 64) * 8 + wave, NGW1 = (G - 64) * 8;
            conv_matrix<1>((const float*)ap->in[23] + (size_t)D * FF, D, FF, fn1, wgu1, 2 * FF, 0, gw1, NGW1, scr, lane);
            conv_matrix<1>((const float*)ap->in[24] + (size_t)D * FF, D, FF, fn1, wgu1, 2 * FF, 1, gw1, NGW1, scr, lane);
            { const int n4 = 2 * M * PLE / 4; const f32x4* p4 = (const f32x4*)pin; u32x2* o2 = (u32x2*)PBF;
              for (int i = ((int)blockIdx.x - 64) * 512 + tid; i < n4; i += (G - 64) * 512) { const f32x4 v = p4[i]; u32x2 w; w.x = cvt_pk_bf16(v.x, v.y); w.y = cvt_pk_bf16(v.z, v.w); o2[i] = w; } }
        }
    PH_END(1)
#if PROBE_DUP1
    PH_BEGIN(1) GEMM_B(0, A, ws + WS_W1, N1P, D, RAW1, nullptr, N1P, nullptr); PH_END(1)
#endif
    PH_BEGIN(2)
            for (int m0 = gw * 4; m0 < M; m0 += NGW * 4) {
                u32x4 v[4][2];
#pragma unroll
                for (int r = 0; r < 4; ++r)
#pragma unroll
                    for (int part = 0; part < 2; ++part) v[r][part] = *(const u32x4*)(RAW1 + (size_t)(m0 + r) * N1P + part * 512 + lane * 8);
#pragma unroll
                for (int r = 0; r < 4; ++r)
#pragma unroll
                    for (int part = 0; part < 2; ++part) {
                        const u32x4 q = v[r][part];
                        const float f0 = bflo(q.x), f1 = bfhi(q.x), f2 = bflo(q.y), f3 = bfhi(q.y), f4 = bflo(q.z), f5 = bfhi(q.z), f6 = bflo(q.w), f7 = bfhi(q.w);
                        const float sq = (f0 * f0 + f1 * f1) + (f2 * f2 + f3 * f3) + (f4 * f4 + f5 * f5) + (f6 * f6 + f7 * f7);
                        const float rstd = __builtin_amdgcn_rsqf(wave_sum(sq) * (1.0f / 512) + EPS);
                        u32x4 w; w.x = cvt_pk_bf16(f0 * rstd, f1 * rstd); w.y = cvt_pk_bf16(f2 * rstd, f3 * rstd); w.z = cvt_pk_bf16(f4 * rstd, f5 * rstd); w.w = cvt_pk_bf16(f6 * rstd, f7 * rstd);
                        *(u32x4*)((part ? CKVN : CQN) + (size_t)(m0 + r) * 512 + lane * 8) = w;
                    }
            }
    PH_END(2)
    PH_BEGIN(3) GEMM_B(0, CQN, ws + WS_WUQ, 3072, 512, QA, nullptr, 3072, nullptr); GEMM_B(1, CKVN, ws + WS_WUKV, 4096, 512, KN, VA, 2048, nullptr); PH_END(3)
#if PROBE_DUP3
    PH_BEGIN(3) GEMM_B(0, CQN, ws + WS_WUQ, 3072, 512, QA, nullptr, 3072, nullptr); GEMM_B(1, CKVN, ws + WS_WUKV, 4096, 512, KN, VA, 2048, nullptr); PH_END(3)
#endif
    PH_BEGIN(4)
            const float* g_kn = (const float*)ap->in[11];
            const float gk0 = g_kn[lane], gk1 = g_kn[64 + lane], gk2 = g_kn[128 + lane];
            const float invf = exp2f(-(float)(lane & 31) * (13.287712379549449f / 32.0f));
            const float sgn = (lane < 32) ? -1.0f : 1.0f;
            float* CSt = (float*)(ws + WS_ROPE); float* SNt = CSt + (size_t)M * 32;
            for (int m = gw; m < M; m += NGW) {
                const bf16_t* knrow = KN + (size_t)m * 2048; bf16_t* krow = KA + (size_t)m * 3072;
                unsigned short ka[NH], kb[NH];
#pragma unroll
                for (int h = 0; h < NH; ++h) { ka[h] = knrow[h * 128 + lane]; kb[h] = knrow[h * 128 + 64 + lane]; }
                const float kpe = bf2f(RAW1[(size_t)m * N1P + 1024 + lane]);
                const float ang = (float)positions[m] * invf;
                const double red = (double)ang - 6.283185307179586 * rint((double)ang * 0.15915494309189535);
                const float cs = cosf((float)red), sn = sinf((float)red);
                if (lane < 32) { CSt[(size_t)m * 32 + lane] = cs; SNt[(size_t)m * 32 + lane] = sn; }
#pragma unroll
                for (int h = 0; h < NH; ++h) {
                    float a = bf2f(ka[h]), b = bf2f(kb[h]), c = kpe;
                    const float rstd = __builtin_amdgcn_rsqf(wave_sum(a * a + b * b + c * c) * (1.0f / 192) + EPS);
                    a *= rstd * gk0; b *= rstd * gk1; c *= rstd * gk2;
                    const float pr = __shfl_xor(c, 32); c = c * cs + sgn * pr * sn;
                    krow[h * 192 + lane] = (bf16_t)(cvt_pk_bf16(a, 0.f) & 0xffffu); krow[h * 192 + 64 + lane] = (bf16_t)(cvt_pk_bf16(b, 0.f) & 0xffffu); krow[h * 192 + 128 + lane] = (bf16_t)(cvt_pk_bf16(c, 0.f) & 0xffffu);
                }
            }
    PH_END(4)
    PH_BEGIN(5) { AttnP P{QA, 3072, 192, KA, 3072, 192, VA, 2048, 128, OA, 2048, nullptr, positions, (const float*)ap->in[10], (const float*)(ws + WS_ROPE), (const float*)(ws + WS_ROPE) + (size_t)M * 32}; for (int rep = 0; rep < REP_P5; ++rep) { if (rep) grid.sync(); attn_phase<192, false>(lds, P, tid); } } PH_END(5)
    PH_BEGIN(6) GEMM_R(0, 0, OA, ws + WS_WOA, D, x, nullptr, nullptr, nullptr, A, SS, nullptr, D, (size_t)128, 0); PH_END(6)
    PH_BEGIN(8) GEMM_B(2, A, ws + WS_WGU0, 2 * FF, D, HB, nullptr, FF, SS); PH_END(8)
#if PROBE_DUP8
    PH_BEGIN(8) GEMM_B(2, A, ws + WS_WGU0, 2 * FF, D, HB, nullptr, FF, SS); PH_END(8)
#endif
    PH_BEGIN(9) GEMM_R(0, 1, HB, ws + WS_WD0, FF, nullptr, A, nullptr, nullptr, A, SS + M, nullptr, 64, (size_t)M * 128, 0); GEMM_B(0, PBF, ws + WS_WEP0, D, PLE, PP, nullptr, D, nullptr); PH_END(9)
    PH_BEGIN(11) GEMM_R(1, 1, A, ws + WS_WEG0, D, nullptr, A, nullptr, PP, AB, SS + 2 * M, SS + M, D, (size_t)128, 0); PH_END(11)
    PH_BEGIN(13) GEMM_B(0, AB, ws + WS_WSKVQ, 6144, D, RAW3, nullptr, 6144, SS + 2 * M); PH_END(13)
#if PROBE_DUP13
    PH_BEGIN(13) GEMM_B(0, AB, ws + WS_WSKVQ, 6144, D, RAW3, nullptr, 6144, SS + 2 * M); PH_END(13)
#endif
    PH_BEGIN(14)
            const float* gk = (const float*)ap->in[16];
            const float gk0 = gk[2 * lane], gk1 = gk[2 * lane + 1];
            for (int m = gw; m < M; m += NGW) {
                unsigned* row = (unsigned*)(RAW3 + (size_t)m * 6144);
                unsigned kw[NH];
#pragma unroll
                for (int h = 0; h < NH; ++h) kw[h] = row[h * 64 + lane];
#pragma unroll
                for (int h = 0; h < NH; ++h) {
                    const float a = bflo(kw[h]), b = bfhi(kw[h]);
                    const float rstd = __builtin_amdgcn_rsqf(wave_sum(a * a + b * b) * (1.0f / 128) + EPS);
                    row[h * 64 + lane] = cvt_pk_bf16(a * rstd * gk0, b * rstd * gk1);
                }
            }
    PH_END(14)
    PH_BEGIN(15) { AttnP P{RAW3 + 4096, 6144, 128, RAW3, 6144, 128, RAW3 + 2048, 6144, 128, OB, 2048, (const float*)ap->in[20], positions, (const float*)ap->in[19], nullptr, nullptr}; for (int rep = 0; rep < REP_P15; ++rep) { if (rep) grid.sync(); attn_phase<128, true>(lds, P, tid); } }
        if ((G & 3) == 0 && ((int)blockIdx.x & 3) < 2) {
            __syncthreads();
            LAS float* scr = (LAS float*)(lds + wave * 16384);
            const int j3 = ((int)blockIdx.x >> 2) * 3, NGW1 = (G >> 2) * 3 * 8;
            if (((int)blockIdx.x & 3) == 0) { conv_matrix<0>((const float*)ap->in[25] + (size_t)FF * D, FF, D, nullptr, (bf16_t*)(ws + WS_WD1), D, 0, j3 * 8 + wave, NGW1, scr, lane);
                                              conv_matrix<0>((const float*)ap->in[25] + (size_t)FF * D, FF, D, nullptr, (bf16_t*)(ws + WS_WD1), D, 0, (j3 + 1) * 8 + wave, NGW1, scr, lane); }
            else conv_matrix<0>((const float*)ap->in[25] + (size_t)FF * D, FF, D, nullptr, (bf16_t*)(ws + WS_WD1), D, 0, (j3 + 2) * 8 + wave, NGW1, scr, lane);
        }
    PH_END(15)
    PH_BEGIN(16) GEMM_R(0, 1, OB, ws + WS_WOB, D, nullptr, AB, nullptr, nullptr, A, SS + 3 * M, nullptr, D, (size_t)128, 0); PH_END(16)
    PH_BEGIN(18) GEMM_B(2, A, ws + WS_WGU1, 2 * FF, D, HB, nullptr, FF, SS + 3 * M); PH_END(18)
    PH_BEGIN(19) GEMM_R(0, 1, HB, ws + WS_WD1, FF, nullptr, A, nullptr, nullptr, A, SS + 4 * M, nullptr, 64, (size_t)M * 128, 0); GEMM_B(0, PBF + (size_t)M * PLE, ws + WS_WEP1, D, PLE, PP, nullptr, D, nullptr); PH_END(19)
    PH_BEGIN(21) GEMM_R(1, 1, A, ws + WS_WEG1, D, nullptr, A, out, PP, nullptr, nullptr, SS + 4 * M, D, (size_t)128, 0); PH_END(21)
}

extern "C" void kernel_launch(void* const* d_in, const int* in_sizes, int n_in, void* d_out, int out_size, void* d_ws, size_t ws_size, hipStream_t stream) {
    static int grid = 0;
    if (grid == 0) {
        if (n_in != 29 || out_size != M * D || ws_size < WS_END) { fprintf(stderr, "kernel_launch: unexpected shapes (n_in %d out %d ws %zu)\n", n_in, out_size, ws_size); grid = -1; return; }
        int dev = 0, cus = 0, per_cu = 0;
        hipGetDevice(&dev); hipDeviceGetAttribute(&cus, hipDeviceAttributeMultiprocessorCount, dev);
        hipFuncSetAttribute((const void*)yoco_fwd, hipFuncAttributeMaxDynamicSharedMemorySize, LDS_BYTES);
        hipOccupancyMaxActiveBlocksPerMultiprocessor(&per_cu, (const void*)yoco_fwd, 512, LDS_BYTES);
        if (per_cu < 1) per_cu = 1;
        grid = cus * per_cu;
        (void)hipGetLastError();
    }
    if (grid < 0) return;
    if (hipMemsetAsync((char*)d_ws + WS_BAR, 0, XCD_BAR_WORDS * 4, stream) != hipSuccess) { fprintf(stderr, "kernel_launch: hipMemsetAsync failed\n"); return; }
    Args a{};
    for (int i = 0; i < 29; ++i) a.in[i] = d_in[i];
    a.out = (float*)d_out; a.ws = (unsigned char*)d_ws; a.ph_lo = 0; a.ph_hi = NPHASE;
    void* kargs[] = {&a};
    hipError_t e = hipLaunchCooperativeKernel((const void*)yoco_fwd, dim3(grid), dim3(512), kargs, LDS_BYTES, stream);
    if (e != hipSuccess) fprintf(stderr, "cooperative launch failed: %s (grid %d)\n", hipGetErrorString(e), grid);
}
```

```cpp
#include <hip/hip_runtime.h>
#include <hip/hip_cooperative_groups.h>
#include <cstdio>
#include <cstdint>
namespace cg = cooperative_groups;

#define LAS __attribute__((address_space(3)))
typedef unsigned short bf16_t;
typedef short bf16x8 __attribute__((ext_vector_type(8)));
typedef float f32x4 __attribute__((ext_vector_type(4)));
typedef float f32x16 __attribute__((ext_vector_type(16)));
typedef unsigned u32x4 __attribute__((ext_vector_type(4)));
typedef unsigned u32x2 __attribute__((ext_vector_type(2)));
typedef short s16x4 __attribute__((ext_vector_type(4)));

constexpr int M = 16384, D = 2048, SEQ = 4096, NB = 4, FF = 5632, NH = 16, PLE = 256;
constexpr int N1P = 1280;
constexpr float EPS = 1e-6f, LOG2E = 1.4426950408889634f;

__device__ __forceinline__ unsigned cvt_pk_bf16(float lo, float hi) { unsigned r; asm volatile("v_cvt_pk_bf16_f32 %0, %1, %2" : "=v"(r) : "v"(lo), "v"(hi)); return r; }
__device__ __forceinline__ float bf2f(unsigned u16) { return __uint_as_float(u16 << 16); }
__device__ __forceinline__ float bflo(unsigned w) { return __uint_as_float(w << 16); }
__device__ __forceinline__ float bfhi(unsigned w) { return __uint_as_float(w & 0xffff0000u); }
__device__ __forceinline__ float wave_sum(float v) {
    v = v + __builtin_bit_cast(float, __builtin_amdgcn_update_dpp(0, __builtin_bit_cast(int, v), 0xB1, 0xF, 0xF, true));
    v = v + __builtin_bit_cast(float, __builtin_amdgcn_update_dpp(0, __builtin_bit_cast(int, v), 0x4E, 0xF, 0xF, true));
    v = v + __builtin_bit_cast(float, __builtin_amdgcn_update_dpp(0, __builtin_bit_cast(int, v), 0x141, 0xF, 0xF, true));
    v = v + __builtin_bit_cast(float, __builtin_amdgcn_update_dpp(0, __builtin_bit_cast(int, v), 0x140, 0xF, 0xF, true));
    v += __shfl_xor(v, 16); v += __shfl_xor(v, 32);
    return v;
}
__device__ __forceinline__ float fsigmoid(float a) { return __builtin_amdgcn_rcpf(1.0f + __builtin_amdgcn_exp2f(-a * LOG2E)); }

namespace pg8 {
constexpr int BM = 256, BK = 64, HALF = 128, HTB = HALF * BK * 2, STAGE_BYTES = 8 * HTB, NXCD = 8, WGM = 8;
__host__ __device__ __forceinline__ int lds_byte(int r, int c) { const int st = (r >> 4) * 2 + (c >> 5), rr = r & 15, cc = c & 31, ob = rr * 64 + cc * 2; return st * 1024 + (ob ^ (((ob >> 9) & 1) << 5)); }
__host__ __device__ __forceinline__ void stage_rc(int b, int& R, int& C) { const int st = b / 1024, sb = b % 1024, swz = sb ^ (((sb >> 9) & 1) << 5); R = (st >> 1) * 16 + swz / 64; C = (st & 1) * 32 + (swz % 64) / 2; }
__host__ __device__ __forceinline__ int perm32(int rho) { const int n = rho >> 4, i = rho & 15; return 8 * (i >> 2) + 4 * n + (i & 3); }

struct Unit { int pm, pn; };
struct Gemm { const bf16_t* A; const bf16_t* Bt; int M, N, K; int lda; size_t kstepA; };

struct StaticOrder {
    int nM, nN, nwg, G, c, wgm, rev;
    __device__ void init(int M_, int N_, int G_, int c_, int rev_ = 0) { nM = M_ / BM; nN = N_ / BM; nwg = nM * nN; G = G_; c = c_; wgm = (nN == 8) ? 4 : WGM; rev = rev_; }
    __device__ bool next(int i, Unit& u) const {
        const long L = (long)i * G + c; if (L >= nwg) return false;
        int wgid = (int)L; { const int q = nwg / NXCD, r = nwg % NXCD, xcd = wgid % NXCD, off = wgid / NXCD; wgid = (xcd < r ? xcd * (q + 1) : r * (q + 1) + (xcd - r) * q) + off; }
        const int nig = wgm * nN, gid = wgid / nig, fm = gid * wgm, gsz = (nM - fm) < wgm ? (nM - fm) : wgm;
        u.pm = fm + ((wgid % nig) % gsz); u.pn = (wgid % nig) / gsz; if (rev) u.pm = nM - 1 - u.pm;
        return true;
    }
};

template <int MODE> struct EpiB {
    static constexpr bool PERM = true;
    bf16_t* O0; bf16_t* O1; int ldc; const float* ss_in;
    __device__ __forceinline__ void operator()(const f32x4 (&acc)[2][2][4][2], const Unit& u, int wr, int wc, int fr, int fq) const {
        const int row0 = u.pm * BM + wr * 64 + fr;
        const int col0 = (MODE == 0 ? u.pn * BM : u.pn * HALF) + wc * 32 + 8 * fq;
        float rsv[2][4];
#pragma unroll
        for (int ai = 0; ai < 2; ++ai)
#pragma unroll
            for (int m = 0; m < 4; ++m) rsv[ai][m] = ss_in ? ss_in[row0 + ai * HALF + m * 16] : 0.f;
#pragma unroll
        for (int ai = 0; ai < 2; ++ai)
#pragma unroll
            for (int m = 0; m < 4; ++m) {
                const size_t roff = (size_t)(row0 + ai * HALF + m * 16) * ldc + col0;
                const float rs = ss_in ? __builtin_amdgcn_rsqf(rsv[ai][m] * (1.0f / D) + EPS) : 1.0f;
                if (MODE == 2) {
                    f32x4 g0 = acc[ai][0][m][0] * rs, g1 = acc[ai][0][m][1] * rs, u0 = acc[ai][1][m][0] * rs, u1 = acc[ai][1][m][1] * rs;
#pragma unroll
                    for (int e = 0; e < 4; ++e) { g0[e] = g0[e] * fsigmoid(g0[e]) * u0[e]; g1[e] = g1[e] * fsigmoid(g1[e]) * u1[e]; }
                    u32x4 w; w.x = cvt_pk_bf16(g0[0], g0[1]); w.y = cvt_pk_bf16(g0[2], g0[3]); w.z = cvt_pk_bf16(g1[0], g1[1]); w.w = cvt_pk_bf16(g1[2], g1[3]);
                    { const int col = col0, row = row0 + ai * HALF + m * 16; *(u32x4*)(O0 + ((size_t)(col >> 6) * M + row) * 64 + (col & 63)) = w; }
                } else {
#pragma unroll
                    for (int bj = 0; bj < 2; ++bj) {
                        const f32x4 v0 = acc[ai][bj][m][0] * rs, v1 = acc[ai][bj][m][1] * rs;
                        u32x4 w; w.x = cvt_pk_bf16(v0[0], v0[1]); w.y = cvt_pk_bf16(v0[2], v0[3]); w.z = cvt_pk_bf16(v1[0], v1[1]); w.w = cvt_pk_bf16(v1[2], v1[3]);
                        if (MODE == 0) *(u32x4*)(O0 + roff + bj * HALF) = w;
                        else *(u32x4*)((bj == 0 ? O0 : O1) + roff) = w;
                    }
                }
            }
    }
};
template <int MODE, int BASE> struct EpiF {
    static constexpr bool PERM = false;
    const float* base; const bf16_t* baseb; float* out; const bf16_t* pp; int ldc;
    bf16_t* xb; float* ss_out;
    const float* ss_in;
    __device__ __forceinline__ void operator()(const f32x4 (&acc)[2][2][4][2], const Unit& u, int wr, int wc, int fr, int fq) const {
        const int row0 = u.pm * BM + wr * 64 + fr, col0 = u.pn * BM + wc * 32 + 4 * fq;
        float rsv[2][4];
        if (MODE == 1) {
#pragma unroll
            for (int ai = 0; ai < 2; ++ai)
#pragma unroll
                for (int m = 0; m < 4; ++m) rsv[ai][m] = ss_in[row0 + ai * HALF + m * 16];
        }
#pragma unroll
        for (int ai = 0; ai < 2; ++ai)
#pragma unroll
            for (int mp = 0; mp < 2; ++mp) {
                f32x4 bv[2][2][2]; u32x2 bw[2][2][2]; u32x2 pv[2][2][2];
#pragma unroll
                for (int mi = 0; mi < 2; ++mi)
#pragma unroll
                    for (int bj = 0; bj < 2; ++bj)
#pragma unroll
                        for (int n = 0; n < 2; ++n) {
                            const size_t c = (size_t)(row0 + ai * HALF + (2 * mp + mi) * 16) * ldc + col0 + bj * HALF + n * 16;
                            if (BASE == 0) bv[mi][bj][n] = *(const f32x4*)(base + c); else bw[mi][bj][n] = *(const u32x2*)(baseb + c);
                            if (MODE == 1) pv[mi][bj][n] = *(const u32x2*)(pp + c);
                        }
#pragma unroll
                for (int mi = 0; mi < 2; ++mi) {
                    const int m = 2 * mp + mi, row = row0 + ai * HALF + m * 16;
                    const size_t roff = (size_t)row * ldc + col0;
                    float rs = 1.0f; if (MODE == 1) rs = __builtin_amdgcn_rsqf(rsv[ai][m] * (1.0f / D) + EPS);
                    float sq = 0.f;
#pragma unroll
                    for (int bj = 0; bj < 2; ++bj)
#pragma unroll
                        for (int n = 0; n < 2; ++n) {
                            const size_t c = roff + bj * HALF + n * 16;
                            f32x4 a = acc[ai][bj][m][n];
                            if (MODE == 1) { const u32x2 p2 = pv[mi][bj][n];
                                a[0] = fsigmoid(a[0] * rs) * bflo(p2.x); a[1] = fsigmoid(a[1] * rs) * bfhi(p2.x); a[2] = fsigmoid(a[2] * rs) * bflo(p2.y); a[3] = fsigmoid(a[3] * rs) * bfhi(p2.y); }
                            f32x4 b;
                            if (BASE == 0) b = bv[mi][bj][n]; else { const u32x2 q = bw[mi][bj][n]; b = (f32x4){bflo(q.x), bfhi(q.x), bflo(q.y), bfhi(q.y)}; }
                            const f32x4 o = b + a;
                            if (out) *(f32x4*)(out + c) = o;
                            if (xb) { u32x2 w; w.x = cvt_pk_bf16(o[0], o[1]); w.y = cvt_pk_bf16(o[2], o[3]); *(u32x2*)(xb + c) = w;
                                const float r0 = bflo(w.x), r1 = bfhi(w.x), r2 = bflo(w.y), r3 = bfhi(w.y); sq += (r0 * r0 + r1 * r1) + (r2 * r2 + r3 * r3); }
                        }
                    if (xb) { sq += __shfl_xor(sq, 16); sq += __shfl_xor(sq, 32); if (fq == 0) atomicAdd(ss_out + row, sq); }
                }
            }
    }
};

template <class Epi, class Sched, bool ALIGN_EPI, bool SP2>
__device__ __forceinline__ void gemm_phase(LAS unsigned char* lds, const Gemm g, const Sched& S, const Epi& E, const int tid) {
    const int wid = __builtin_amdgcn_readfirstlane(tid >> 6), lane = tid & 63, wr = wid >> 2, wc = wid & 3, fr = lane & 15, fq = lane >> 4;
    const int K = g.K, nt = K / BK;
    unsigned voffA[2], voffB[2];
#pragma unroll
    for (int i = 0; i < 2; ++i) { int R, C; stage_rc(tid * 16 + i * 8192, R, C); const int Rb = Epi::PERM ? ((R & ~31) + perm32(R & 31)) : R;
        voffA[i] = (unsigned)(R * g.lda + C) * 2u; voffB[i] = (unsigned)(Rb * 64 + C) * 2u; }
    const size_t kstep = (size_t)(BK * 2);
    const size_t hstepA = (size_t)HALF * g.lda * 2, hstepB = (size_t)HALF * 64 * 2;
    const size_t tstepA = 2 * hstepA, tstepB = 2 * hstepB;
    const size_t kstepA = g.kstepA, kstepB = (size_t)g.N * 128;
    const unsigned ldsw = (unsigned)wid * 1024u;
    const int aoff = lds_byte(wr * 64 + fr, fq * 8), boff = lds_byte(wc * 32 + fr, fq * 8);
#define PG8_SA(b, h) (((b) * 2 + (h)) * HTB)
#define PG8_SB(b, h) ((4 + (b) * 2 + (h)) * HTB)
#define PG8_STAGE(bufoff, gbase, voff) do { _Pragma("unroll") for (int _i = 0; _i < 2; ++_i) \
        __builtin_amdgcn_global_load_lds((const unsigned*)((const char*)(gbase) + (voff)[_i]), (LAS unsigned*)(lds + (bufoff) + ldsw + _i * 8192), 16, 0, 0); } while (0)
#define PG8_LDA(dst, b, h) do { _Pragma("unroll") for (int m = 0; m < 4; ++m) _Pragma("unroll") for (int k = 0; k < 2; ++k) dst[m][k] = *(const LAS bf16x8*)(lds + PG8_SA(b, h) + aoff + m * 2048 + k * 1024); } while (0)
#define PG8_LDB(dst, b, h) do { _Pragma("unroll") for (int n = 0; n < 2; ++n) _Pragma("unroll") for (int k = 0; k < 2; ++k) dst[n][k] = *(const LAS bf16x8*)(lds + PG8_SB(b, h) + boff + n * 2048 + k * 1024); } while (0)
#define PG8_MMA(ai, bj, At, Bt) do { __builtin_amdgcn_s_setprio(1); _Pragma("unroll") for (int m = 0; m < 4; ++m) _Pragma("unroll") for (int n = 0; n < 2; ++n) _Pragma("unroll") for (int k = 0; k < 2; ++k) \
        acc[ai][bj][m][n] = __builtin_amdgcn_mfma_f32_16x16x32_bf16(Bt[n][k], At[m][k], acc[ai][bj][m][n], 0, 0, 0); __builtin_amdgcn_s_setprio(0); } while (0)
#define PG8_WAIT_V(n) asm volatile("s_waitcnt vmcnt(" #n ")" ::: "memory")
#define PG8_WAIT_L(n) asm volatile("s_waitcnt lgkmcnt(" #n ")" ::: "memory")
#define PG8_BAR __builtin_amdgcn_s_barrier()
#define PG8_SCHED __builtin_amdgcn_sched_barrier(0)
    Unit cur, nxt; int ui = 0;
    if (!S.next(0, cur)) return;
    f32x4 acc[2][2][4][2];
#pragma unroll
    for (int a = 0; a < 2; ++a)
#pragma unroll
        for (int b = 0; b < 2; ++b)
#pragma unroll
            for (int m = 0; m < 4; ++m)
#pragma unroll
                for (int n = 0; n < 2; ++n) acc[a][b][m][n] = (f32x4){0.f, 0.f, 0.f, 0.f};
    bf16x8 At[4][2], B0[2][2], B1[2][2];
    const char* cA = (const char*)g.A + (size_t)cur.pm * tstepA; const char* cB = (const char*)g.Bt + (size_t)cur.pn * tstepB;
    if constexpr (SP2) {
        PG8_STAGE(PG8_SB(0, 0), cB, voffB); PG8_STAGE(PG8_SB(0, 1), cB + hstepB, voffB); PG8_STAGE(PG8_SA(0, 0), cA, voffA); PG8_STAGE(PG8_SA(0, 1), cA + hstepA, voffA);
        if (wr == 1) PG8_BAR;
        PG8_WAIT_V(2); PG8_BAR;
        PG8_STAGE(PG8_SB(1, 0), cB + kstepB, voffB); PG8_STAGE(PG8_SA(1, 0), cA + kstepA, voffA); PG8_STAGE(PG8_SB(1, 1), cB + hstepB + kstepB, voffB);
        PG8_WAIT_V(6); PG8_BAR;
    } else {
        PG8_STAGE(PG8_SB(0, 0), cB, voffB); PG8_STAGE(PG8_SA(0, 0), cA, voffA); PG8_STAGE(PG8_SB(0, 1), cB + hstepB, voffB); PG8_STAGE(PG8_SA(0, 1), cA + hstepA, voffA);
        if (wr == 1) PG8_BAR;
        PG8_WAIT_V(4); PG8_BAR;
        PG8_STAGE(PG8_SB(1, 0), cB + kstepB, voffB); PG8_STAGE(PG8_SA(1, 0), cA + kstepA, voffA); PG8_STAGE(PG8_SB(1, 1), cB + hstepB + kstepB, voffB);
        PG8_WAIT_V(6); PG8_BAR;
    }
    for (;;) {
        const bool has_next = S.next(ui + 1, nxt);
        const char* nA = has_next ? (const char*)g.A + (size_t)nxt.pm * tstepA : cA; const char* nB = has_next ? (const char*)g.Bt + (size_t)nxt.pn * tstepB : cB;
        for (int t = 0; t < nt; t += 2) {
            const bool last = (t == nt - 2);
            const char* a1 = cA + (size_t)(t + 1) * kstepA;
            const char* a2 = last ? nA : cA + (size_t)(t + 2) * kstepA; const char* b2 = last ? nB : cB + (size_t)(t + 2) * kstepB;
            const char* a3 = a2 + kstepA; const char* b3 = b2 + kstepB;
            if constexpr (SP2) {
            PG8_LDB(B0, 0, 0); PG8_LDB(B1, 0, 1); PG8_SCHED; PG8_LDA(At, 0, 0); PG8_STAGE(PG8_SA(1, 1), a1 + hstepA, voffA);
            PG8_WAIT_V(8); PG8_WAIT_L(0); PG8_BAR; PG8_MMA(0, 0, At, B0); PG8_MMA(0, 1, At, B1); PG8_BAR; PG8_SCHED;
            PG8_LDA(At, 0, 1); PG8_STAGE(PG8_SB(0, 0), b2, voffB); PG8_STAGE(PG8_SB(0, 1), b2 + hstepB, voffB); PG8_STAGE(PG8_SA(0, 0), a2, voffA);
            PG8_WAIT_V(8); PG8_WAIT_L(0); PG8_BAR; PG8_MMA(1, 0, At, B0); PG8_MMA(1, 1, At, B1); PG8_BAR; PG8_SCHED;
            PG8_LDB(B0, 1, 0); PG8_LDB(B1, 1, 1); PG8_SCHED; PG8_LDA(At, 1, 0); PG8_STAGE(PG8_SA(0, 1), a2 + hstepA, voffA);
            PG8_WAIT_V(8); PG8_WAIT_L(0); PG8_BAR; PG8_MMA(0, 0, At, B0); PG8_MMA(0, 1, At, B1); PG8_BAR; PG8_SCHED;
            PG8_LDA(At, 1, 1); PG8_STAGE(PG8_SB(1, 0), b3, voffB); PG8_STAGE(PG8_SB(1, 1), b3 + hstepB, voffB); PG8_STAGE(PG8_SA(1, 0), a3, voffA);
            PG8_WAIT_V(8); PG8_WAIT_L(0); PG8_BAR; PG8_MMA(1, 0, At, B0); PG8_MMA(1, 1, At, B1); PG8_BAR; PG8_SCHED;
            } else {
            PG8_LDB(B0, 0, 0); PG8_SCHED; PG8_LDA(At, 0, 0); PG8_STAGE(PG8_SA(1, 1), a1 + hstepA, voffA);
            PG8_WAIT_L(8); PG8_BAR; PG8_WAIT_L(0); PG8_MMA(0, 0, At, B0); PG8_BAR; PG8_SCHED;
            PG8_LDB(B1, 0, 1); PG8_STAGE(PG8_SB(0, 0), b2, voffB);
            PG8_BAR; PG8_WAIT_L(0); PG8_MMA(0, 1, At, B1); PG8_BAR;
            PG8_LDA(At, 0, 1); PG8_STAGE(PG8_SA(0, 0), a2, voffA);
            PG8_BAR; PG8_WAIT_L(0); PG8_MMA(1, 0, At, B0); PG8_BAR; PG8_SCHED;
            PG8_STAGE(PG8_SB(0, 1), b2 + hstepB, voffB);
            PG8_WAIT_V(6); PG8_BAR; PG8_MMA(1, 1, At, B1); PG8_BAR;
            PG8_LDB(B0, 1, 0); PG8_SCHED; PG8_LDA(At, 1, 0); PG8_STAGE(PG8_SA(0, 1), a2 + hstepA, voffA);
            PG8_WAIT_L(8); PG8_BAR; PG8_WAIT_L(0); PG8_MMA(0, 0, At, B0); PG8_BAR; PG8_SCHED;
            PG8_LDB(B1, 1, 1); PG8_STAGE(PG8_SB(1, 0), b3, voffB);
            PG8_BAR; PG8_WAIT_L(0); PG8_MMA(0, 1, At, B1); PG8_BAR;
            PG8_LDA(At, 1, 1); PG8_STAGE(PG8_SA(1, 0), a3, voffA);
            PG8_BAR; PG8_WAIT_L(0); PG8_MMA(1, 0, At, B0); PG8_BAR; PG8_SCHED;
            PG8_STAGE(PG8_SB(1, 1), b3 + hstepB, voffB);
            PG8_WAIT_V(6); PG8_BAR; PG8_MMA(1, 1, At, B1); PG8_BAR;
            }
        }
        if constexpr (ALIGN_EPI) { if (wr == 0) PG8_BAR; }
        E(acc, cur, wr, wc, fr, fq);
        if (!has_next) break;
#pragma unroll
        for (int a = 0; a < 2; ++a)
#pragma unroll
            for (int b = 0; b < 2; ++b)
#pragma unroll
                for (int m = 0; m < 4; ++m)
#pragma unroll
                    for (int n = 0; n < 2; ++n) acc[a][b][m][n] = (f32x4){0.f, 0.f, 0.f, 0.f};
        cur = nxt; cA = nA; cB = nB; ++ui;
        if constexpr (ALIGN_EPI) { if (wr == 1) PG8_BAR; }
    }
    PG8_WAIT_V(0);
    if constexpr (!ALIGN_EPI) { if (wr == 0) PG8_BAR; }
    PG8_BAR;
#undef PG8_SA
#undef PG8_SB
#undef PG8_STAGE
#undef PG8_LDA
#undef PG8_LDB
#undef PG8_MMA
#undef PG8_WAIT_V
#undef PG8_WAIT_L
#undef PG8_BAR
#undef PG8_SCHED
}
}

struct AttnP { const bf16_t* Q; int ldq, hsq; const bf16_t* K; int ldk, hsk; const bf16_t* V; int ldv, hsv; bf16_t* O; int ldo; const float* bias; const int* pos; const float* gq; const float* cs; const float* sn; };
__device__ __forceinline__ int crow(int r, int hi) { return (r & 3) + 8 * (r >> 2) + 4 * hi; }

template <int DQK, bool BAND>
__device__ __forceinline__ void attn_phase(LAS unsigned char* lds, const AttnP P, const int tid) {
    constexpr int SK = DQK * 2 + 16, SV = 320;
    constexpr int KBYTES = 64 * SK, VBYTES = 64 * SV, BUF = KBYTES + VBYTES;
    constexpr int OFF_KPOS = 2 * BUF, OFF_BIAS = OFF_KPOS + 512, OFF_KMAX = OFF_BIAS + 2112;
    constexpr int CPR = DQK / 8, NKC = 64 * CPR / 512, NDS = DQK / 16;
    const int lane = tid & 63, r32 = lane & 31, hi = lane >> 5;
    const int wid = __builtin_amdgcn_readfirstlane(tid >> 6);
    LAS int* kposL = (LAS int*)(lds + OFF_KPOS);
    LAS float* biasL = (LAS float*)(lds + OFF_BIAS);
    LAS int* kmaxL = (LAS int*)(lds + OFF_KMAX);
    constexpr int NUNITS = NB * NH * (SEQ / 256);
    for (int ui = blockIdx.x; ui < NUNITS; ui += gridDim.x) {
        const int jr = ui >> 8, vv = ui & 255, bh = vv >> 2, s4 = vv & 3;
        const int qb = (jr == 0) ? s4 : (jr == 1) ? 7 - s4 : (jr == 2) ? 8 + s4 : 15 - s4;
        const int b = bh / NH, h = bh % NH;
        const size_t rowbase = (size_t)b * SEQ; const int q0 = qb * 256;
        const int cw = 4 * qb + (wid >> 1);
        const int t_lo = BAND ? (4 * qb - 8 > 0 ? 4 * qb - 8 : 0) : 0, t_hi = 4 * qb + 3;
        const int w_lo = BAND ? (cw - 8 > 0 ? cw - 8 : 0) : 0, w_hi = cw;
        bf16x8 qf[NDS];
        { const bf16_t* qp = P.Q + (rowbase + q0 + wid * 32 + r32) * P.ldq + h * P.hsq + hi * 8;
#pragma unroll
          for (int ds = 0; ds < NDS; ++ds) qf[ds] = *(const bf16x8*)(qp + ds * 16); }
        {
            float ssq = 0.f;
#pragma unroll
            for (int ds = 0; ds < NDS; ++ds)
#pragma unroll
                for (int e = 0; e < 8; ++e) { const float v = bf2f((unsigned)(unsigned short)qf[ds][e]); ssq += v * v; }
            ssq += __shfl_xor(ssq, 32);
            const float rq = __builtin_amdgcn_rsqf(ssq * (1.0f / DQK) + EPS) * ((BAND ? 0.08838834764831845f : 0.07216878364870322f) * LOG2E);
            const size_t tok = rowbase + q0 + wid * 32 + r32;
#pragma unroll
            for (int ds = 0; ds < 8; ++ds) {
                const f32x4 g0 = *(const f32x4*)(P.gq + ds * 16 + hi * 8), g1 = *(const f32x4*)(P.gq + ds * 16 + hi * 8 + 4);
                u32x4 w;
                w.x = cvt_pk_bf16(bf2f((unsigned)(unsigned short)qf[ds][0]) * rq * g0[0], bf2f((unsigned)(unsigned short)qf[ds][1]) * rq * g0[1]);
                w.y = cvt_pk_bf16(bf2f((unsigned)(unsigned short)qf[ds][2]) * rq * g0[2], bf2f((unsigned)(unsigned short)qf[ds][3]) * rq * g0[3]);
                w.z = cvt_pk_bf16(bf2f((unsigned)(unsigned short)qf[ds][4]) * rq * g1[0], bf2f((unsigned)(unsigned short)qf[ds][5]) * rq * g1[1]);
                w.w = cvt_pk_bf16(bf2f((unsigned)(unsigned short)qf[ds][6]) * rq * g1[2], bf2f((unsigned)(unsigned short)qf[ds][7]) * rq * g1[3]);
                qf[ds] = __builtin_bit_cast(bf16x8, w);
            }
            if (!BAND)
#pragma unroll
            for (int j = 0; j < 2; ++j) {
                const int i0 = 16 * j + 8 * hi;
                float o1[8], o2[8];
                const f32x4 cA = *(const f32x4*)(P.cs + tok * 32 + i0), cB = *(const f32x4*)(P.cs + tok * 32 + i0 + 4), sA = *(const f32x4*)(P.sn + tok * 32 + i0), sB = *(const f32x4*)(P.sn + tok * 32 + i0 + 4);
                const f32x4 g1A = *(const f32x4*)(P.gq + 128 + i0), g1B = *(const f32x4*)(P.gq + 128 + i0 + 4), g2A = *(const f32x4*)(P.gq + 160 + i0), g2B = *(const f32x4*)(P.gq + 160 + i0 + 4);
#pragma unroll
                for (int e = 0; e < 8; ++e) {
                    const float c = e < 4 ? cA[e & 3] : cB[e & 3], sn_ = e < 4 ? sA[e & 3] : sB[e & 3];
                    const float x1 = bf2f((unsigned)(unsigned short)qf[8 + j][e]) * rq * (e < 4 ? g1A[e & 3] : g1B[e & 3]), x2 = bf2f((unsigned)(unsigned short)qf[10 + j][e]) * rq * (e < 4 ? g2A[e & 3] : g2B[e & 3]);
                    o1[e] = x1 * c - x2 * sn_; o2[e] = x2 * c + x1 * sn_;
                }
                u32x4 w1, w2;
                w1.x = cvt_pk_bf16(o1[0], o1[1]); w1.y = cvt_pk_bf16(o1[2], o1[3]); w1.z = cvt_pk_bf16(o1[4], o1[5]); w1.w = cvt_pk_bf16(o1[6], o1[7]);
                w2.x = cvt_pk_bf16(o2[0], o2[1]); w2.y = cvt_pk_bf16(o2[2], o2[3]); w2.z = cvt_pk_bf16(o2[4], o2[5]); w2.w = cvt_pk_bf16(o2[6], o2[7]);
                qf[8 + j] = __builtin_bit_cast(bf16x8, w1); qf[10 + j] = __builtin_bit_cast(bf16x8, w2);
            }
        }
        int qpos = 0;
        if (BAND) { for (int i = tid; i < 513; i += 512) biasL[i] = P.bias[h * 513 + i] * LOG2E; qpos = P.pos[rowbase + q0 + wid * 32 + r32]; }
        int qmin = qpos;
        if (BAND) {
#pragma unroll
            for (int o = 1; o < 64; o <<= 1) { const int t_ = __shfl_xor(qmin, o); qmin = t_ < qmin ? t_ : qmin; }
        }
        f32x16 o[4];
#pragma unroll
        for (int d = 0; d < 4; ++d)
#pragma unroll
            for (int r = 0; r < 16; ++r) o[d][r] = 0.f;
        float mrun = -1e30f, lrun = 0.f;
        u32x4 kreg[NKC], vreg[2]; int kpreg = 0;
        const bf16_t* Kh = P.K + rowbase * P.ldk + h * P.hsk; const bf16_t* Vh = P.V + rowbase * P.ldv + h * P.hsv;
        unsigned kgo[NKC], klo[NKC], vgo[2], vlo[2];
#pragma unroll
        for (int i = 0; i < NKC; ++i) { const int c = tid + i * 512, row = c / CPR, cc = c % CPR; kgo[i] = (unsigned)(row * P.ldk + cc * 8); klo[i] = (unsigned)(row * SK + cc * 16); }
#pragma unroll
        for (int i = 0; i < 2; ++i) { const int c = tid + i * 512, row = c >> 4, cc = c & 15; vgo[i] = (unsigned)(row * P.ldv + cc * 8); vlo[i] = (unsigned)(KBYTES + row * SV + cc * 16); }
#define ATT_BAR() do { asm volatile("s_waitcnt lgkmcnt(0)" ::: "memory"); __builtin_amdgcn_s_barrier(); asm volatile("" ::: "memory"); } while (0)
#define ATT_LOADK(t) do { const bf16_t* kt_ = Kh + (size_t)(t) * 64 * P.ldk; _Pragma("unroll") for (int i = 0; i < NKC; ++i) kreg[i] = *(const u32x4*)(kt_ + kgo[i]); } while (0)
#define ATT_LOADV(t) do { const bf16_t* vt_ = Vh + (size_t)(t) * 64 * P.ldv; _Pragma("unroll") for (int i = 0; i < 2; ++i) vreg[i] = *(const u32x4*)(vt_ + vgo[i]); \
        if (BAND) { if (tid < 64) kpreg = P.pos[rowbase + (t) * 64 + tid]; } } while (0)
#define ATT_STOREK(bufi) do { LAS unsigned char* kb_ = lds + (bufi) * BUF; _Pragma("unroll") for (int i = 0; i < NKC; ++i) *(LAS u32x4*)(kb_ + klo[i]) = kreg[i]; } while (0)
#define ATT_STOREV(bufi) do { LAS unsigned char* kb_ = lds + (bufi) * BUF; _Pragma("unroll") for (int i = 0; i < 2; ++i) *(LAS u32x4*)(kb_ + vlo[i]) = vreg[i]; \
        if (BAND) { if (tid < 64) { kposL[(bufi) * 64 + tid] = kpreg; int mx_ = kpreg; _Pragma("unroll") for (int o = 1; o < 64; o <<= 1) { const int t_ = __shfl_xor(mx_, o); mx_ = t_ > mx_ ? t_ : mx_; } if (tid == 0) kmaxL[(bufi)] = mx_; } } } while (0)
        ATT_LOADK(t_lo); ATT_LOADV(t_lo); ATT_STOREK(0); ATT_STOREV(0); __syncthreads();
        const int grp = wid >> 2;
        { const int t1 = t_lo < t_hi ? t_lo + 1 : t_hi; ATT_LOADK(t1); ATT_LOADV(t1); }
        if (grp == 1) ATT_BAR();
        for (int t = t_lo; t <= t_hi; ++t) {
            const int cur = (t - t_lo) & 1;
            const int tn = t + 2 < t_hi ? t + 2 : t_hi;
            const bool part = (t >= w_lo && t <= w_hi);
            const LAS unsigned char* Kb = lds + cur * BUF; const LAS unsigned char* Vb = Kb + KBYTES;
            f32x16 p0, p1;
            if (part) {
#pragma unroll
                for (int r = 0; r < 16; ++r) { p0[r] = 0.f; p1[r] = 0.f; }
#pragma unroll
                for (int ds = 0; ds < NDS; ++ds) {
                    const bf16x8 k0 = *(const LAS bf16x8*)(Kb + r32 * SK + ds * 32 + hi * 16);
                    const bf16x8 k1 = *(const LAS bf16x8*)(Kb + (32 + r32) * SK + ds * 32 + hi * 16);
                    p0 = __builtin_amdgcn_mfma_f32_32x32x16_bf16(k0, qf[ds], p0, 0, 0, 0);
                    p1 = __builtin_amdgcn_mfma_f32_32x32x16_bf16(k1, qf[ds], p1, 0, 0, 0);
                    if ((ds & 1) == 1) __builtin_amdgcn_sched_barrier(0);
                }
            }
            ATT_STOREK(cur ^ 1); ATT_LOADK(tn);
            ATT_BAR();
            if (part) {
                if (BAND && qmin - kmaxL[cur] >= 256) {
                    const float bc = biasL[512];
#pragma unroll
                    for (int r = 0; r < 16; ++r) { p0[r] += bc; p1[r] += bc; }
                } else if (BAND) {
#pragma unroll
                    for (int r = 0; r < 16; ++r) { const int key = crow(r, hi);
                        int r0 = qpos - kposL[cur * 64 + key], r1 = qpos - kposL[cur * 64 + 32 + key];
                        r0 = (r0 < -256 ? -256 : (r0 > 256 ? 256 : r0)) + 256; r1 = (r1 < -256 ? -256 : (r1 > 256 ? 256 : r1)) + 256;
                        p0[r] += biasL[r0]; p1[r] += biasL[r1]; }
                }
                float mx = p0[0];
#pragma unroll
                for (int r = 1; r < 16; ++r) mx = fmaxf(mx, p0[r]);
#pragma unroll
                for (int r = 0; r < 16; ++r) mx = fmaxf(mx, p1[r]);
                mx = fmaxf(mx, __shfl_xor(mx, 32));
                if (__any(mx > mrun + 6.0f)) {
                    const float mnew = fmaxf(mrun, mx), alpha = __builtin_amdgcn_exp2f(mrun - mnew); mrun = mnew;
                    lrun *= alpha;
#pragma unroll
                    for (int d = 0; d < 4; ++d)
#pragma unroll
                        for (int r = 0; r < 16; ++r) o[d][r] *= alpha;
                }
                float ls = 0.f;
#pragma unroll
                for (int r = 0; r < 16; ++r) { p0[r] = __builtin_amdgcn_exp2f(p0[r] - mrun); p1[r] = __builtin_amdgcn_exp2f(p1[r] - mrun); ls += p0[r] + p1[r]; }
                lrun += ls;
                const LAS unsigned char* vbase = Vb + (4 * hi + ((lane & 15) >> 2)) * SV + (16 * ((lane >> 4) & 1) + 4 * (lane & 3)) * 2;
#pragma unroll
                for (int kb = 0; kb < 2; ++kb)
#pragma unroll
                    for (int s = 0; s < 2; ++s) {
                        u32x4 pw;
                        if (kb == 0) { pw.x = cvt_pk_bf16(p0[8 * s + 0], p0[8 * s + 1]); pw.y = cvt_pk_bf16(p0[8 * s + 2], p0[8 * s + 3]); pw.z = cvt_pk_bf16(p0[8 * s + 4], p0[8 * s + 5]); pw.w = cvt_pk_bf16(p0[8 * s + 6], p0[8 * s + 7]); }
                        else         { pw.x = cvt_pk_bf16(p1[8 * s + 0], p1[8 * s + 1]); pw.y = cvt_pk_bf16(p1[8 * s + 2], p1[8 * s + 3]); pw.z = cvt_pk_bf16(p1[8 * s + 4], p1[8 * s + 5]); pw.w = cvt_pk_bf16(p1[8 * s + 6], p1[8 * s + 7]); }
                        const bf16x8 pb = __builtin_bit_cast(bf16x8, pw);
#pragma unroll
                        for (int d = 0; d < 4; ++d) {
                            const LAS unsigned char* ap = vbase + (32 * kb + 16 * s) * SV + d * 64;
                            const s16x4 lo = __builtin_bit_cast(s16x4, __builtin_amdgcn_ds_read_tr16_b64_v4i16((LAS s16x4*)ap));
                            const s16x4 h4 = __builtin_bit_cast(s16x4, __builtin_amdgcn_ds_read_tr16_b64_v4i16((LAS s16x4*)(ap + 8 * SV)));
                            const bf16x8 va = (bf16x8){lo[0], lo[1], lo[2], lo[3], h4[0], h4[1], h4[2], h4[3]};
                            o[d] = __builtin_amdgcn_mfma_f32_32x32x16_bf16(va, pb, o[d], 0, 0, 0);
                        }
                        __builtin_amdgcn_sched_barrier(0);
                    }
            }
            ATT_STOREV(cur ^ 1); ATT_LOADV(tn);
            ATT_BAR();
        }
        if (grp == 0) ATT_BAR();
#undef ATT_BAR
#undef ATT_LOADK
#undef ATT_LOADV
#undef ATT_STOREK
#undef ATT_STOREV
        const float ltot = lrun + __shfl_xor(lrun, 32), inv = 1.0f / ltot;
        bf16_t* op = P.O + (rowbase + q0 + wid * 32 + r32) * P.ldo + h * 128 + 4 * hi;
#pragma unroll
        for (int d = 0; d < 4; ++d)
#pragma unroll
            for (int g4 = 0; g4 < 4; ++g4) {
                u32x2 w; w.x = cvt_pk_bf16(o[d][4 * g4 + 0] * inv, o[d][4 * g4 + 1] * inv); w.y = cvt_pk_bf16(o[d][4 * g4 + 2] * inv, o[d][4 * g4 + 3] * inv);
                *(u32x2*)(op + 32 * d + 8 * g4) = w;
            }
    }
}

constexpr size_t MiB = 1u << 20;
constexpr size_t WS_W1 = 1 * MiB, WS_WUQ = 6 * MiB, WS_WUKV = 9 * MiB, WS_WOA = 13 * MiB, WS_WGU0 = 21 * MiB, WS_WGU1 = 65 * MiB, WS_WD0 = 109 * MiB, WS_WD1 = 131 * MiB,
                 WS_WEG0 = 153 * MiB, WS_WEG1 = 161 * MiB, WS_WEP0 = 169 * MiB, WS_WEP1 = 170 * MiB, WS_WSKVQ = 171 * MiB, WS_WOB = 195 * MiB;
constexpr size_t WS_PBF = 203 * MiB;
constexpr size_t WS_A = 219 * MiB;
constexpr size_t WS_PP = 283 * MiB;
constexpr size_t WS_RAW1 = 347 * MiB;
constexpr size_t WS_KA = 387 * MiB;
constexpr size_t WS_CQN = 387 * MiB, WS_CKVN = 403 * MiB;
constexpr size_t WS_H = 347 * MiB;
constexpr size_t WS_RAW3 = 219 * MiB;
constexpr size_t WS_AB = 475 * MiB;
constexpr size_t WS_OB = 411 * MiB;
constexpr size_t WS_SS = 65536;
constexpr size_t WS_ROPE = 500 * MiB;
constexpr size_t WS_END = 539 * MiB;
constexpr int LDS_BYTES = 135168;
constexpr int NPHASE = 22;
constexpr int REP_P0 = 1, REP_P5 = 1, REP_P7 = 1, REP_P15 = 1, EXTRA_SYNCS = 0;
#define PROBE_DUP8 0
#define PROBE_DUP13 0
#define PROBE_DUP6 0
#define PROBE_DUP1 0
#define PROBE_DUP3 0

#define XB_TMO      128
#define XB_XCNT(j)  (256  + 64 * (j))
#define XB_XSUB(j)  (1280 + 64 * (j))
#define XB_XGEN(j)  (2304 + 64 * (j))
#define XB_TOP      3328
#define XB_TOPGEN   3392
#define XCD_BAR_WORDS 3456
#define XB_SPIN_CAP (1u << 18)

__device__ __forceinline__ unsigned xb_ld(unsigned* p)              { return __hip_atomic_load(p, __ATOMIC_RELAXED, __HIP_MEMORY_SCOPE_AGENT); }
__device__ __forceinline__ unsigned xb_add(unsigned* p, unsigned v) { return __hip_atomic_fetch_add(p, v, __ATOMIC_RELAXED, __HIP_MEMORY_SCOPE_AGENT); }
__device__ __forceinline__ unsigned xb_xcc_id() { return (unsigned)__builtin_amdgcn_s_getreg((3 << 11) | 20) & 0xFu; }
#define XB_SPIN(cond, bar) do { unsigned _sp = 0; while (cond) { __builtin_amdgcn_s_sleep(1); \
    if ((++_sp & 255u) == 0u) { if (xb_ld(&(bar)[XB_TMO])) break; if (_sp > XB_SPIN_CAP) { atomicAdd(&(bar)[XB_TMO], 1u); break; } } } } while (0)

struct XcdBarrier {
    unsigned* bar; unsigned x;
    volatile LAS unsigned* st;
};

__device__ __forceinline__ XcdBarrier xcd_barrier_post(unsigned* bar, volatile LAS unsigned* st) {
    XcdBarrier b; b.bar = bar; b.x = xb_xcc_id(); b.st = st;
    if (threadIdx.x == 0) (void)xb_add(&bar[XB_XCNT(b.x)], 1u);
    return b;
}
__device__ __forceinline__ void xcd_barrier_complete(unsigned* bar, unsigned x, unsigned& nloc, unsigned& nx) {
    const unsigned G = gridDim.x * gridDim.y * gridDim.z;
    unsigned sum, cnt, mine, sp = 0u;
    for (;;) {
        sum = 0u; cnt = 0u; mine = 0u;
#pragma unroll
        for (unsigned j = 0; j < 16; ++j) { const unsigned c = xb_ld(&bar[XB_XCNT(j)]); sum += c; cnt += (c > 0u) ? 1u : 0u; mine = (j == x) ? c : mine; }
        if (sum == G) break;
        __builtin_amdgcn_s_sleep(1);
        if ((++sp & 255u) == 0u) { if (xb_ld(&bar[XB_TMO])) break; if (sp > XB_SPIN_CAP) { atomicAdd(&bar[XB_TMO], 1u); break; } }
    }
    nloc = mine > 0u ? mine : 1u; nx = cnt > 0u ? cnt : 1u;
}

__device__ __forceinline__ void xcd_barrier(const XcdBarrier& b) {
    asm volatile("s_waitcnt vmcnt(0)" ::: "memory");
    __syncthreads();
    if (threadIdx.x == 0) {
        unsigned* bar = b.bar;
        __builtin_amdgcn_s_waitcnt(0);
        unsigned nloc = b.st[0], nx = b.st[1];
        if (nloc == 0u) { xcd_barrier_complete(bar, b.x, nloc, nx); b.st[0] = nloc; b.st[1] = nx; }
        const unsigned old = xb_add(&bar[XB_XSUB(b.x)], 1u);
        const unsigned gen = old / nloc;
        if (old + 1u == (gen + 1u) * nloc) {
            __builtin_amdgcn_fence(__ATOMIC_RELEASE, "agent");
            asm volatile("s_waitcnt vmcnt(0)" ::: "memory");
            const unsigned og = xb_add(&bar[XB_TOP], 1u);
            const unsigned tg = og / nx;
            if (og + 1u == (tg + 1u) * nx) xb_add(&bar[XB_TOPGEN], 1u);
            else XB_SPIN(xb_ld(&bar[XB_TOPGEN]) == tg, bar);
            __builtin_amdgcn_fence(__ATOMIC_ACQUIRE, "agent");
            xb_add(&bar[XB_XGEN(b.x)], 1u);
            asm volatile("s_waitcnt vmcnt(0)" ::: "memory");
        } else {
            XB_SPIN(xb_ld(&bar[XB_XGEN(b.x)]) == gen, bar);
            __builtin_amdgcn_fence(__ATOMIC_ACQUIRE, "agent");
            asm volatile("s_waitcnt vmcnt(0)" ::: "memory");
        }
    }
    __syncthreads();
}


constexpr size_t WS_BAR = 16384;
constexpr int LDS_MISC = 131072 + 64;

struct Args { const void* in[29]; float* out; unsigned char* ws; int ph_lo, ph_hi; };

__device__ __forceinline__ void tr_item(const float* W, int N, const float* g, bf16_t* WT, int ldk, int drow, int k0, int n0, LAS float* scr, int lane) {
    float v[32];
    const float* wp = W + (size_t)(k0 + (lane >> 5)) * N + n0 + (lane & 31);
#pragma unroll
    for (int i = 0; i < 32; ++i) v[i] = __builtin_nontemporal_load(wp + (size_t)(2 * i) * N);
    if (g) {
#pragma unroll
        for (int i = 0; i < 32; ++i) v[i] *= g[k0 + 2 * i + (lane >> 5)];
    }
#pragma unroll
    for (int i = 0; i < 32; ++i) scr[(2 * i + (lane >> 5)) * 33 + (lane & 31)] = v[i];
    asm volatile("s_waitcnt lgkmcnt(0)" ::: "memory");
    const int c = lane & 7;
#pragma unroll
    for (int j = 0; j < 4; ++j) { const int n = (lane >> 3) + 8 * j; const LAS float* s = scr + (8 * c) * 33 + n;
        u32x4 o; o.x = cvt_pk_bf16(s[0 * 33], s[1 * 33]); o.y = cvt_pk_bf16(s[2 * 33], s[3 * 33]); o.z = cvt_pk_bf16(s[4 * 33], s[5 * 33]); o.w = cvt_pk_bf16(s[6 * 33], s[7 * 33]);
        *(u32x4*)(WT + ((size_t)(k0 >> 6) * ldk + drow + n) * 64 + 8 * c) = o; }
    asm volatile("s_waitcnt lgkmcnt(0)" ::: "memory");
}
template <int KIND>
__device__ __forceinline__ void conv_matrix(const float* W, int K, int N, const float* g, bf16_t* WT, int NR, int row_off, int gw, int NGW, LAS float* scr, int lane) {
    const int nblk = N / 32, nitems = (K / 64) * nblk;
    for (int it = gw; it < nitems; it += NGW) { const int kb = it / nblk, nb = it % nblk, n0 = 32 * nb;
        const int drow = KIND == 0 ? row_off + n0 : ((n0 >> 7) * 256 + row_off * 128 + (n0 & 127));
        tr_item(W, N, g, WT, NR, drow, 64 * kb, n0, scr, lane); }
}
__device__ __forceinline__ void rms_row(const float* xrow, bf16_t* orow, int lane) {
    const f32x4* xr = (const f32x4*)xrow + lane;
    f32x4 v[8]; float s = 0.f;
#pragma unroll
    for (int j = 0; j < 8; ++j) { v[j] = xr[64 * j]; s += (v[j].x * v[j].x + v[j].y * v[j].y) + (v[j].z * v[j].z + v[j].w * v[j].w); }
    const float rstd = __builtin_amdgcn_rsqf(wave_sum(s) * (1.0f / D) + EPS);
    u32x2* o8 = (u32x2*)orow + lane;
#pragma unroll
    for (int j = 0; j < 8; ++j) { u32x2 w; w.x = cvt_pk_bf16(v[j].x * rstd, v[j].y * rstd); w.y = cvt_pk_bf16(v[j].z * rstd, v[j].w * rstd); o8[64 * j] = w; }
}

#define PH_BEGIN(k) if (ph_lo <= (k) && (k) < ph_hi) { \
        int tid = wave_s * 64 + (int)__builtin_amdgcn_mbcnt_hi(~0u, __builtin_amdgcn_mbcnt_lo(~0u, 0u)); asm volatile("" : "+v"(tid)); \
        const __attribute__((address_space(4))) Args* ap = (const __attribute__((address_space(4))) Args*)__builtin_amdgcn_kernarg_segment_ptr(); asm volatile("" : "+s"(ap)); \
        const int lane = tid & 63, wave = __builtin_amdgcn_readfirstlane(tid >> 6), gw = blockIdx.x * 8 + wave, NGW = G * 8; \
        unsigned char* ws = ap->ws; float* out = ap->out; \
        const float* x = (const float*)ap->in[0]; const float* pin = (const float*)ap->in[1]; const int* positions = (const int*)ap->in[2]; \
        bf16_t* A = (bf16_t*)(ws + WS_A); bf16_t* PP = (bf16_t*)(ws + WS_PP); bf16_t* PBF = (bf16_t*)(ws + WS_PBF); \
        bf16_t* RAW1 = (bf16_t*)(ws + WS_RAW1); bf16_t* KA = (bf16_t*)(ws + WS_KA); bf16_t* CQN = (bf16_t*)(ws + WS_CQN); bf16_t* CKVN = (bf16_t*)(ws + WS_CKVN); \
        bf16_t* HB = (bf16_t*)(ws + WS_H); bf16_t* RAW3 = (bf16_t*)(ws + WS_RAW3); \
        bf16_t* QA = (bf16_t*)out; bf16_t* VA = A; bf16_t* KN = PP; bf16_t* OA = PP; bf16_t* OB = (bf16_t*)(ws + WS_OB); bf16_t* AB = (bf16_t*)(ws + WS_AB); float* SS = (float*)(ws + WS_SS); \
        (void)lane; (void)wave; (void)gw; (void)NGW; (void)x; (void)pin; (void)positions; (void)PBF; (void)RAW1; (void)KA; (void)CQN; (void)CKVN; (void)HB; (void)RAW3; (void)QA; (void)VA; (void)KN; (void)OA; (void)OB; (void)AB; (void)SS;
#define PH_END(k) if ((k) + 1 < ph_hi) { if (ph_hi > NPHASE) grid.sync(); else xcd_barrier(xbar); } }
#define GEMM_B(MODE, Aptr, Bptr, Nv, Kv, O0v, O1v, ldcv, ssin) do { pg8::Gemm g{Aptr, (const bf16_t*)(Bptr), M, Nv, Kv, Kv, (size_t)128}; pg8::StaticOrder So; So.init(M, Nv, G, (int)blockIdx.x); \
        pg8::EpiB<MODE> E{O0v, O1v, ldcv, ssin}; pg8::gemm_phase<pg8::EpiB<MODE>, pg8::StaticOrder, true, true>(lds, g, So, E, tid); } while (0)
#define GEMM_BX(MODE, ALIGN, Aptr, Bptr, Nv, Kv, O0v, O1v, ldcv, ssin) do { pg8::Gemm g{Aptr, (const bf16_t*)(Bptr), M, Nv, Kv, Kv, (size_t)128}; pg8::StaticOrder So; So.init(M, Nv, G, (int)blockIdx.x); \
        pg8::EpiB<MODE> E{O0v, O1v, ldcv, ssin}; pg8::gemm_phase<pg8::EpiB<MODE>, pg8::StaticOrder, ALIGN, true>(lds, g, So, E, tid); } while (0)
#define GEMM_R(MODE, BASE, Aptr, Bptr, Kv, basefv, basebv, outv, ppv, xbv, ssoutv, ssinv, ldav, kstepv, revv) do { pg8::Gemm g{Aptr, (const bf16_t*)(Bptr), M, D, Kv, ldav, kstepv}; pg8::StaticOrder So; So.init(M, D, G, (int)blockIdx.x, revv); \
        pg8::EpiF<MODE, BASE> E{basefv, basebv, outv, ppv, D, xbv, ssoutv, ssinv}; pg8::gemm_phase<pg8::EpiF<MODE, BASE>, pg8::StaticOrder, true, true>(lds, g, So, E, tid); } while (0)
#define NORM_PASS() do { for (int m = gw; m < M; m += NGW) rms_row(out + (size_t)m * D, A + (size_t)m * D, lane); } while (0)

__global__ void __launch_bounds__(512, 2) yoco_fwd(Args args) {
    extern __shared__ __attribute__((aligned(16))) unsigned char lds_raw[];
    LAS unsigned char* lds = (LAS unsigned char*)lds_raw;
    cg::grid_group grid = cg::this_grid();
    const int G = gridDim.x, ph_lo = args.ph_lo, ph_hi = args.ph_hi;
    const int wave_s = __builtin_amdgcn_readfirstlane(threadIdx.x >> 6);
    if (threadIdx.x < 2) ((volatile LAS unsigned*)(lds + LDS_MISC))[threadIdx.x] = 0u;
    __syncthreads();
    XcdBarrier xbar = xcd_barrier_post((unsigned*)(args.ws + WS_BAR), (volatile LAS unsigned*)(lds + LDS_MISC));

    PH_BEGIN(0)
        for (int i = blockIdx.x * 512 + tid; i < 5 * M; i += G * 512) SS[i] = 0.f;
        for (int rep = 0; rep < REP_P0; ++rep) { if (rep) grid.sync();
            LAS float* scr = (LAS float*)(lds + wave * 16384);
            const float* a_norm = (const float*)ap->in[3];
            conv_matrix<0>((const float*)ap->in[4], D, 512, a_norm, (bf16_t*)(ws + WS_W1), N1P, 0, gw, NGW, scr, lane);
            conv_matrix<0>((const float*)ap->in[7], D, 576, a_norm, (bf16_t*)(ws + WS_W1), N1P, 512, gw, NGW, scr, lane);
            { const int per = 192 * 64 * 2 / 16, nz = (D / 64) * per; for (int i = blockIdx.x * 512 + tid; i < nz; i += G * 512) { const int kt = i / per, j = i % per; ((u32x4*)((bf16_t*)(ws + WS_W1) + ((size_t)kt * N1P + 1088) * 64))[j] = (u32x4){0u, 0u, 0u, 0u}; } }
            conv_matrix<0>((const float*)ap->in[6], 512, 3072, (const float*)ap->in[5], (bf16_t*)(ws + WS_WUQ), 3072, 0, gw, NGW, scr, lane);
            conv_matrix<0>((const float*)ap->in[9], 512, 4096, (const float*)ap->in[8], (bf16_t*)(ws + WS_WUKV), 4096, 0, gw, NGW, scr, lane);
            conv_matrix<0>((const float*)ap->in[12], D, D, nullptr, (bf16_t*)(ws + WS_WOA), D, 0, gw, NGW, scr, lane);
            conv_matrix<0>((const float*)ap->in[14], D, D, (const float*)ap->in[13], (bf16_t*)(ws + WS_WSKVQ), 6144, 0, gw, NGW, scr, lane);
            conv_matrix<0>((const float*)ap->in[15], D, D, (const float*)ap->in[13], (bf16_t*)(ws + WS_WSKVQ), 6144, 2048, gw, NGW, scr, lane);
            conv_matrix<0>((const float*)ap->in[18], D, D, (const float*)ap->in[17], (bf16_t*)(ws + WS_WSKVQ), 6144, 4096, gw, NGW, scr, lane);
            conv_matrix<0>((const float*)ap->in[21], D, D, nullptr, (bf16_t*)(ws + WS_WOB), D, 0, gw, NGW, scr, lane);
            for (int l = 0; l < 2; ++l) {
                const float* fn = (const float*)ap->in[22] + l * D; const float* en = (const float*)ap->in[26] + l * D;
                bf16_t* wgu = (bf16_t*)(ws + (l ? WS_WGU1 : WS_WGU0));
                if (l == 0 || G <= 64) conv_matrix<1>((const float*)ap->in[23] + (size_t)l * D * FF, D, FF, fn, wgu, 2 * FF, 0, gw, NGW, scr, lane);
                if (l == 0 || G <= 64) conv_matrix<1>((const float*)ap->in[24] + (size_t)l * D * FF, D, FF, fn, wgu, 2 * FF, 1, gw, NGW, scr, lane);
                if (l == 0 || (G & 3) != 0) conv_matrix<0>((const float*)ap->in[25] + (size_t)l * FF * D, FF, D, nullptr, (bf16_t*)(ws + (l ? WS_WD1 : WS_WD0)), D, 0, gw, NGW, scr, lane);
                conv_matrix<0>((const float*)ap->in[27] + (size_t)l * D * D, D, D, en, (bf16_t*)(ws + (l ? WS_WEG1 : WS_WEG0)), D, 0, gw, NGW, scr, lane);
                conv_matrix<0>((const float*)ap->in[28] + (size_t)l * PLE * D, PLE, D, nullptr, (bf16_t*)(ws + (l ? WS_WEP1 : WS_WEP0)), D, 0, gw, NGW, scr, lane);
            }
            if (G <= 64) { const int n4 = 2 * M * PLE / 4; const f32x4* p4 = (const f32x4*)pin; u32x2* o2 = (u32x2*)PBF;
              for (int i = blockIdx.x * 512 + tid; i < n4; i += G * 512) { const f32x4 v = p4[i]; u32x2 w; w.x = cvt_pk_bf16(v.x, v.y); w.y = cvt_pk_bf16(v.z, v.w); o2[i] = w; } }
            for (int m = gw; m < M; m += NGW) rms_row(x + (size_t)m * D, A + (size_t)m * D, lane);
        }
    PH_END(0)
    PH_BEGIN(1) GEMM_B(0, A, ws + WS_W1, N1P, D, RAW1, nullptr, N1P, nullptr);
        if (G > 64 && (int)blockIdx.x >= 64) {
            LAS float* scr = (LAS float*)(lds + wave * 16384);
            const float* fn1 = (const float*)ap->in[22] + D; bf16_t* wgu1 = (bf16_t*)(ws + WS_WGU1);
            const int gw1 = ((int)blockIdx.x - 64) * 8 + wave, NGW1 = (G - 64) * 8;
            conv_matrix<1>((const float*)ap->in[23] + (size_t)D * FF, D, FF, fn1, wgu1, 2 * FF, 0, gw1, NGW1, scr, lane);
            conv_matrix<1>((const float*)ap->in[24] + (size_t)D * FF, D, FF, fn1, wgu1, 2 * FF, 1, gw1, NGW1, scr, lane);
            { const int n4 = 2 * M * PLE / 4; const f32x4* p4 = (const f32x4*)pin; u32x2* o2 = (u32x2*)PBF;
              for (int i = ((int)blockIdx.x - 64) * 512 + tid; i < n4; i += (G - 64) * 512) { const f32x4 v = p4[i]; u32x2 w; w.x = cvt_pk_bf16(v.x, v.y); w.y = cvt_pk_bf16(v.z, v.w); o2[i] = w; } }
        }
    PH_END(1)
#if PROBE_DUP1
    PH_BEGIN(1) GEMM_B(0, A, ws + WS_W1, N1P, D, RAW1, nullptr, N1P, nullptr); PH_END(1)
#endif
    PH_BEGIN(2)
            for (int m0 = gw * 4; m0 < M; m0 += NGW * 4) {
                u32x4 v[4][2];
#pragma unroll
                for (int r = 0; r < 4; ++r)
#pragma unroll
                    for (int part = 0; part < 2; ++part) v[r][part] = *(const u32x4*)(RAW1 + (size_t)(m0 + r) * N1P + part * 512 + lane * 8);
#pragma unroll
                for (int r = 0; r < 4; ++r)
#pragma unroll
                    for (int part = 0; part < 2; ++part) {
                        const u32x4 q = v[r][part];
                        const float f0 = bflo(q.x), f1 = bfhi(q.x), f2 = bflo(q.y), f3 = bfhi(q.y), f4 = bflo(q.z), f5 = bfhi(q.z), f6 = bflo(q.w), f7 = bfhi(q.w);
                        const float sq = (f0 * f0 + f1 * f1) + (f2 * f2 + f3 * f3) + (f4 * f4 + f5 * f5) + (f6 * f6 + f7 * f7);
                        const float rstd = __builtin_amdgcn_rsqf(wave_sum(sq) * (1.0f / 512) + EPS);
                        u32x4 w; w.x = cvt_pk_bf16(f0 * rstd, f1 * rstd); w.y = cvt_pk_bf16(f2 * rstd, f3 * rstd); w.z = cvt_pk_bf16(f4 * rstd, f5 * rstd); w.w = cvt_pk_bf16(f6 * rstd, f7 * rstd);
                        *(u32x4*)((part ? CKVN : CQN) + (size_t)(m0 + r) * 512 + lane * 8) = w;
                    }
            }
    PH_END(2)
    PH_BEGIN(3) GEMM_B(0, CQN, ws + WS_WUQ, 3072, 512, QA, nullptr, 3072, nullptr); GEMM_B(1, CKVN, ws + WS_WUKV, 4096, 512, KN, VA, 2048, nullptr); PH_END(3)
#if PROBE_DUP3
    PH_BEGIN(3) GEMM_B(0, CQN, ws + WS_WUQ, 3072, 512, QA, nullptr, 3072, nullptr); GEMM_B(1, CKVN, ws + WS_WUKV, 4096, 512, KN, VA, 2048, nullptr); PH_END(3)
#endif
    PH_BEGIN(4)
            const float* g_kn = (const float*)ap->in[11];
            const float gk0 = g_kn[lane], gk1 = g_kn[64 + lane], gk2 = g_kn[128 + lane];
            const float invf = exp2f(-(float)(lane & 31) * (13.287712379549449f / 32.0f));
            const float sgn = (lane < 32) ? -1.0f : 1.0f;
            float* CSt = (float*)(ws + WS_ROPE); float* SNt = CSt + (size_t)M * 32;
            for (int m = gw; m < M; m += NGW) {
                const bf16_t* knrow = KN + (size_t)m * 2048; bf16_t* krow = KA + (size_t)m * 3072;
                unsigned short ka[NH], kb[NH];
#pragma unroll
                for (int h = 0; h < NH; ++h) { ka[h] = knrow[h * 128 + lane]; kb[h] = knrow[h * 128 + 64 + lane]; }
                const float kpe = bf2f(RAW1[(size_t)m * N1P + 1024 + lane]);
                const float ang = (float)positions[m] * invf;
                const double red = (double)ang - 6.283185307179586 * rint((double)ang * 0.15915494309189535);
                const float cs = cosf((float)red), sn = sinf((float)red);
                if (lane < 32) { CSt[(size_t)m * 32 + lane] = cs; SNt[(size_t)m * 32 + lane] = sn; }
#pragma unroll
                for (int h = 0; h < NH; ++h) {
                    float a = bf2f(ka[h]), b = bf2f(kb[h]), c = kpe;
                    const float rstd = __builtin_amdgcn_rsqf(wave_sum(a * a + b * b + c * c) * (1.0f / 192) + EPS);
                    a *= rstd * gk0; b *= rstd * gk1; c *= rstd * gk2;
                    const float pr = __shfl_xor(c, 32); c = c * cs + sgn * pr * sn;
                    krow[h * 192 + lane] = (bf16_t)(cvt_pk_bf16(a, 0.f) & 0xffffu); krow[h * 192 + 64 + lane] = (bf16_t)(cvt_pk_bf16(b, 0.f) & 0xffffu); krow[h * 192 + 128 + lane] = (bf16_t)(cvt_pk_bf16(c, 0.f) & 0xffffu);
                }
            }
    PH_END(4)
    PH_BEGIN(5) { AttnP P{QA, 3072, 192, KA, 3072, 192, VA, 2048, 128, OA, 2048, nullptr, positions, (const float*)ap->in[10], (const float*)(ws + WS_ROPE), (const float*)(ws + WS_ROPE) + (size_t)M * 32}; for (int rep = 0; rep < REP_P5; ++rep) { if (rep) grid.sync(); attn_phase<192, false>(lds, P, tid); } } PH_END(5)
    PH_BEGIN(6) GEMM_R(0, 0, OA, ws + WS_WOA, D, x, nullptr, nullptr, nullptr, A, SS, nullptr, D, (size_t)128, 0); PH_END(6)
    PH_BEGIN(8) GEMM_B(2, A, ws + WS_WGU0, 2 * FF, D, HB, nullptr, FF, SS); PH_END(8)
#if PROBE_DUP8
    PH_BEGIN(8) GEMM_B(2, A, ws + WS_WGU0, 2 * FF, D, HB, nullptr, FF, SS); PH_END(8)
#endif
    PH_BEGIN(9) GEMM_R(0, 1, HB, ws + WS_WD0, FF, nullptr, A, nullptr, nullptr, A, SS + M, nullptr, 64, (size_t)M * 128, 0); GEMM_B(0, PBF, ws + WS_WEP0, D, PLE, PP, nullptr, D, nullptr); PH_END(9)
    PH_BEGIN(11) GEMM_R(1, 1, A, ws + WS_WEG0, D, nullptr, A, nullptr, PP, AB, SS + 2 * M, SS + M, D, (size_t)128, 0); PH_END(11)
    PH_BEGIN(13) GEMM_B(0, AB, ws + WS_WSKVQ, 6144, D, RAW3, nullptr, 6144, SS + 2 * M); PH_END(13)
#if PROBE_DUP13
    PH_BEGIN(13) GEMM_B(0, AB, ws + WS_WSKVQ, 6144, D, RAW3, nullptr, 6144, SS + 2 * M); PH_END(13)
#endif
    PH_BEGIN(14)
            const float* gk = (const float*)ap->in[16];
            const float gk0 = gk[2 * lane], gk1 = gk[2 * lane + 1];
            for (int m = gw; m < M; m += NGW) {
                unsigned* row = (unsigned*)(RAW3 + (size_t)m * 6144);
                unsigned kw[NH];
#pragma unroll
                for (int h = 0; h < NH; ++h) kw[h] = row[h * 64 + lane];
#pragma unroll
                for (int h = 0; h < NH; ++h) {
                    const float a = bflo(kw[h]), b = bfhi(kw[h]);
                    const float rstd = __builtin_amdgcn_rsqf(wave_sum(a * a + b * b) * (1.0f / 128) + EPS);
                    row[h * 64 + lane] = cvt_pk_bf16(a * rstd * gk0, b * rstd * gk1);
                }
            }
    PH_END(14)
    PH_BEGIN(15) { AttnP P{RAW3 + 4096, 6144, 128, RAW3, 6144, 128, RAW3 + 2048, 6144, 128, OB, 2048, (const float*)ap->in[20], positions, (const float*)ap->in[19], nullptr, nullptr}; for (int rep = 0; rep < REP_P15; ++rep) { if (rep) grid.sync(); attn_phase<128, true>(lds, P, tid); } }
        if ((G & 3) == 0 && ((int)blockIdx.x & 3) < 2) {
            __syncthreads();
            LAS float* scr = (LAS float*)(lds + wave * 16384);
            const int j3 = ((int)blockIdx.x >> 2) * 3, NGW1 = (G >> 2) * 3 * 8;
            if (((int)blockIdx.x & 3) == 0) { conv_matrix<0>((const float*)ap->in[25] + (size_t)FF * D, FF, D, nullptr, (bf16_t*)(ws + WS_WD1), D, 0, j3 * 8 + wave, NGW1, scr, lane);
                                              conv_matrix<0>((const float*)ap->in[25] + (size_t)FF * D, FF, D, nullptr, (bf16_t*)(ws + WS_WD1), D, 0, (j3 + 1) * 8 + wave, NGW1, scr, lane); }
            else conv_matrix<0>((const float*)ap->in[25] + (size_t)FF * D, FF, D, nullptr, (bf16_t*)(ws + WS_WD1), D, 0, (j3 + 2) * 8 + wave, NGW1, scr, lane);
        }
    PH_END(15)
    PH_BEGIN(16) GEMM_R(0, 1, OB, ws + WS_WOB, D, nullptr, AB, nullptr, nullptr, A, SS + 3 * M, nullptr, D, (size_t)128, 0); PH_END(16)
    PH_BEGIN(18) GEMM_B(2, A, ws + WS_WGU1, 2 * FF, D, HB, nullptr, FF, SS + 3 * M); PH_END(18)
    PH_BEGIN(19) GEMM_R(0, 1, HB, ws + WS_WD1, FF, nullptr, A, nullptr, nullptr, A, SS + 4 * M, nullptr, 64, (size_t)M * 128, 0); GEMM_B(0, PBF + (size_t)M * PLE, ws + WS_WEP1, D, PLE, PP, nullptr, D, nullptr); PH_END(19)
    PH_BEGIN(21) GEMM_R(1, 1, A, ws + WS_WEG1, D, nullptr, A, out, PP, nullptr, nullptr, SS + 4 * M, D, (size_t)128, 0); PH_END(21)
}

extern "C" void kernel_launch(void* const* d_in, const int* in_sizes, int n_in, void* d_out, int out_size, void* d_ws, size_t ws_size, hipStream_t stream) {
    static int grid = 0;
    if (grid == 0) {
        if (n_in != 29 || out_size != M * D || ws_size < WS_END) { fprintf(stderr, "kernel_launch: unexpected shapes (n_in %d out %d ws %zu)\n", n_in, out_size, ws_size); grid = -1; return; }
        int dev = 0, cus = 0, per_cu = 0;
        hipGetDevice(&dev); hipDeviceGetAttribute(&cus, hipDeviceAttributeMultiprocessorCount, dev);
        hipFuncSetAttribute((const void*)yoco_fwd, hipFuncAttributeMaxDynamicSharedMemorySize, LDS_BYTES);
        hipOccupancyMaxActiveBlocksPerMultiprocessor(&per_cu, (const void*)yoco_fwd, 512, LDS_BYTES);
        if (per_cu < 1) per_cu = 1;
        grid = cus * per_cu;
        (void)hipGetLastError();
    }
    if (grid < 0) return;
    if (hipMemsetAsync((char*)d_ws + WS_BAR, 0, XCD_BAR_WORDS * 4, stream) != hipSuccess) { fprintf(stderr, "kernel_launch: hipMemsetAsync failed\n"); return; }
    Args a{};
    for (int i = 0; i < 29; ++i) a.in[i] = d_in[i];
    a.out = (float*)d_out; a.ws = (unsigned char*)d_ws; a.ph_lo = 0; a.ph_hi = NPHASE;
    void* kargs[] = {&a};
    hipError_t e = hipLaunchCooperativeKernel((const void*)yoco_fwd, dim3(grid), dim3(512), kargs, LDS_BYTES, stream);
    if (e != hipSuccess) fprintf(stderr, "cooperative launch failed: %s (grid %d)\n", hipGetErrorString(e), grid);
}
```

```cpp
#include <hip/hip_runtime.h>
#include <hip/hip_cooperative_groups.h>
#include <cstdio>
#include <cstdint>
namespace cg = cooperative_groups;

#define LAS __attribute__((address_space(3)))
typedef unsigned short bf16_t;
typedef short bf16x8 __attribute__((ext_vector_type(8)));
typedef float f32x4 __attribute__((ext_vector_type(4)));
typedef float f32x16 __attribute__((ext_vector_type(16)));
typedef unsigned u32x4 __attribute__((ext_vector_type(4)));
typedef unsigned u32x2 __attribute__((ext_vector_type(2)));
typedef short s16x4 __attribute__((ext_vector_type(4)));

constexpr int M = 16384, D = 2048, SEQ = 4096, NB = 4, FF = 5632, NH = 16, PLE = 256;
constexpr int N1P = 1280;
constexpr float EPS = 1e-6f, LOG2E = 1.4426950408889634f;

__device__ __forceinline__ unsigned cvt_pk_bf16(float lo, float hi) { unsigned r; asm volatile("v_cvt_pk_bf16_f32 %0, %1, %2" : "=v"(r) : "v"(lo), "v"(hi)); return r; }
__device__ __forceinline__ float bf2f(unsigned u16) { return __uint_as_float(u16 << 16); }
__device__ __forceinline__ float bflo(unsigned w) { return __uint_as_float(w << 16); }
__device__ __forceinline__ float bfhi(unsigned w) { return __uint_as_float(w & 0xffff0000u); }
__device__ __forceinline__ float wave_sum(float v) {
    v = v + __builtin_bit_cast(float, __builtin_amdgcn_update_dpp(0, __builtin_bit_cast(int, v), 0xB1, 0xF, 0xF, true));
    v = v + __builtin_bit_cast(float, __builtin_amdgcn_update_dpp(0, __builtin_bit_cast(int, v), 0x4E, 0xF, 0xF, true));
    v = v + __builtin_bit_cast(float, __builtin_amdgcn_update_dpp(0, __builtin_bit_cast(int, v), 0x141, 0xF, 0xF, true));
    v = v + __builtin_bit_cast(float, __builtin_amdgcn_update_dpp(0, __builtin_bit_cast(int, v), 0x140, 0xF, 0xF, true));
    v += __shfl_xor(v, 16);
    { const auto rr = __builtin_amdgcn_permlane32_swap(__float_as_uint(v), __float_as_uint(v), false, false); v = __uint_as_float(rr[0]) + __uint_as_float(rr[1]); }
    return v;
}
__device__ __forceinline__ float fsigmoid(float a) { return __builtin_amdgcn_rcpf(1.0f + __builtin_amdgcn_exp2f(-a * LOG2E)); }

namespace pg8 {
constexpr int BM = 256, BK = 64, HALF = 128, HTB = HALF * BK * 2, STAGE_BYTES = 8 * HTB, NXCD = 8, WGM = 8;
__host__ __device__ __forceinline__ int lds_byte(int r, int c) { const int st = (r >> 4) * 2 + (c >> 5), rr = r & 15, cc = c & 31, ob = rr * 64 + cc * 2; return st * 1024 + (ob ^ (((ob >> 9) & 1) << 5)); }
__host__ __device__ __forceinline__ void stage_rc(int b, int& R, int& C) { const int st = b / 1024, sb = b % 1024, swz = sb ^ (((sb >> 9) & 1) << 5); R = (st >> 1) * 16 + swz / 64; C = (st & 1) * 32 + (swz % 64) / 2; }
__host__ __device__ __forceinline__ int perm32(int rho) { const int n = rho >> 4, i = rho & 15; return 8 * (i >> 2) + 4 * n + (i & 3); }

struct Unit { int pm, pn; };
struct Gemm { const bf16_t* A; const bf16_t* Bt; int M, N, K; int lda; size_t kstepA; };

struct StaticOrder {
    int nM, nN, nwg, G, c, wgm, rev;
    __device__ void init(int M_, int N_, int G_, int c_, int rev_ = 0) { nM = M_ / BM; nN = N_ / BM; nwg = nM * nN; G = G_; c = c_; wgm = (nN == 8) ? 4 : WGM; rev = rev_; }
    __device__ bool next(int i, Unit& u) const {
        const long L = (long)i * G + c; if (L >= nwg) return false;
        int wgid = (int)L; { const int q = nwg / NXCD, r = nwg % NXCD, xcd = wgid % NXCD, off = wgid / NXCD; wgid = (xcd < r ? xcd * (q + 1) : r * (q + 1) + (xcd - r) * q) + off; }
        const int nig = wgm * nN, gid = wgid / nig, fm = gid * wgm, gsz = (nM - fm) < wgm ? (nM - fm) : wgm;
        u.pm = fm + ((wgid % nig) % gsz); u.pn = (wgid % nig) / gsz; if (rev) u.pm = nM - 1 - u.pm;
        return true;
    }
};

template <int MODE> struct EpiB {
    static constexpr bool PERM = true;
    bf16_t* O0; bf16_t* O1; int ldc; const float* ss_in;
    __device__ __forceinline__ void operator()(const f32x4 (&acc)[2][2][4][2], const Unit& u, int wr, int wc, int fr, int fq) const {
        const int row0 = u.pm * BM + wr * 64 + fr;
        const int col0 = (MODE == 0 ? u.pn * BM : u.pn * HALF) + wc * 32 + 8 * fq;
        float rsv[2][4];
#pragma unroll
        for (int ai = 0; ai < 2; ++ai)
#pragma unroll
            for (int m = 0; m < 4; ++m) rsv[ai][m] = ss_in ? ss_in[row0 + ai * HALF + m * 16] : 0.f;
#pragma unroll
        for (int ai = 0; ai < 2; ++ai)
#pragma unroll
            for (int m = 0; m < 4; ++m) {
                const size_t roff = (size_t)(row0 + ai * HALF + m * 16) * ldc + col0;
                const float rs = ss_in ? __builtin_amdgcn_rsqf(rsv[ai][m] * (1.0f / D) + EPS) : 1.0f;
                if (MODE == 2) {
                    f32x4 g0 = acc[ai][0][m][0] * rs, g1 = acc[ai][0][m][1] * rs, u0 = acc[ai][1][m][0] * rs, u1 = acc[ai][1][m][1] * rs;
#pragma unroll
                    for (int e = 0; e < 4; ++e) { g0[e] = g0[e] * fsigmoid(g0[e]) * u0[e]; g1[e] = g1[e] * fsigmoid(g1[e]) * u1[e]; }
                    u32x4 w; w.x = cvt_pk_bf16(g0[0], g0[1]); w.y = cvt_pk_bf16(g0[2], g0[3]); w.z = cvt_pk_bf16(g1[0], g1[1]); w.w = cvt_pk_bf16(g1[2], g1[3]);
                    { const int col = col0, row = row0 + ai * HALF + m * 16; *(u32x4*)(O0 + ((size_t)(col >> 6) * M + row) * 64 + (col & 63)) = w; }
                } else {
#pragma unroll
                    for (int bj = 0; bj < 2; ++bj) {
                        const f32x4 v0 = acc[ai][bj][m][0] * rs, v1 = acc[ai][bj][m][1] * rs;
                        u32x4 w; w.x = cvt_pk_bf16(v0[0], v0[1]); w.y = cvt_pk_bf16(v0[2], v0[3]); w.z = cvt_pk_bf16(v1[0], v1[1]); w.w = cvt_pk_bf16(v1[2], v1[3]);
                        if (MODE == 0) *(u32x4*)(O0 + roff + bj * HALF) = w;
                        else *(u32x4*)((bj == 0 ? O0 : O1) + roff) = w;
                    }
                }
            }
    }
};
template <int MODE, int BASE> struct EpiF {
    static constexpr bool PERM = false;
    const float* base; const bf16_t* baseb; float* out; const bf16_t* pp; int ldc;
    bf16_t* xb; float* ss_out;
    const float* ss_in;
    __device__ __forceinline__ void operator()(const f32x4 (&acc)[2][2][4][2], const Unit& u, int wr, int wc, int fr, int fq) const {
        const int row0 = u.pm * BM + wr * 64 + fr, col0 = u.pn * BM + wc * 32 + 4 * fq;
        float rsv[2][4];
        if (MODE == 1) {
#pragma unroll
            for (int ai = 0; ai < 2; ++ai)
#pragma unroll
                for (int m = 0; m < 4; ++m) rsv[ai][m] = ss_in[row0 + ai * HALF + m * 16];
        }
#pragma unroll
        for (int ai = 0; ai < 2; ++ai)
#pragma unroll
            for (int mp = 0; mp < 2; ++mp) {
                f32x4 bv[2][2][2]; u32x2 bw[2][2][2]; u32x2 pv[2][2][2];
#pragma unroll
                for (int mi = 0; mi < 2; ++mi)
#pragma unroll
                    for (int bj = 0; bj < 2; ++bj)
#pragma unroll
                        for (int n = 0; n < 2; ++n) {
                            const size_t c = (size_t)(row0 + ai * HALF + (2 * mp + mi) * 16) * ldc + col0 + bj * HALF + n * 16;
                            if (BASE == 0) bv[mi][bj][n] = *(const f32x4*)(base + c); else bw[mi][bj][n] = *(const u32x2*)(baseb + c);
                            if (MODE == 1) pv[mi][bj][n] = *(const u32x2*)(pp + c);
                        }
#pragma unroll
                for (int mi = 0; mi < 2; ++mi) {
                    const int m = 2 * mp + mi, row = row0 + ai * HALF + m * 16;
                    const size_t roff = (size_t)row * ldc + col0;
                    float rs = 1.0f; if (MODE == 1) rs = __builtin_amdgcn_rsqf(rsv[ai][m] * (1.0f / D) + EPS);
                    float sq = 0.f;
#pragma unroll
                    for (int bj = 0; bj < 2; ++bj)
#pragma unroll
                        for (int n = 0; n < 2; ++n) {
                            const size_t c = roff + bj * HALF + n * 16;
                            f32x4 a = acc[ai][bj][m][n];
                            if (MODE == 1) { const u32x2 p2 = pv[mi][bj][n];
                                a[0] = fsigmoid(a[0] * rs) * bflo(p2.x); a[1] = fsigmoid(a[1] * rs) * bfhi(p2.x); a[2] = fsigmoid(a[2] * rs) * bflo(p2.y); a[3] = fsigmoid(a[3] * rs) * bfhi(p2.y); }
                            f32x4 b;
                            if (BASE == 0) b = bv[mi][bj][n]; else { const u32x2 q = bw[mi][bj][n]; b = (f32x4){bflo(q.x), bfhi(q.x), bflo(q.y), bfhi(q.y)}; }
                            const f32x4 o = b + a;
                            if (out) *(f32x4*)(out + c) = o;
                            if (xb) { u32x2 w; w.x = cvt_pk_bf16(o[0], o[1]); w.y = cvt_pk_bf16(o[2], o[3]); *(u32x2*)(xb + c) = w;
                                const float r0 = bflo(w.x), r1 = bfhi(w.x), r2 = bflo(w.y), r3 = bfhi(w.y); sq += (r0 * r0 + r1 * r1) + (r2 * r2 + r3 * r3); }
                        }
                    if (xb) { sq += __shfl_xor(sq, 16); sq += __shfl_xor(sq, 32); if (fq == 0) atomicAdd(ss_out + row, sq); }
                }
            }
    }
};

template <class Epi, class Sched, bool ALIGN_EPI, bool SP2>
__device__ __forceinline__ void gemm_phase(LAS unsigned char* lds, const Gemm g, const Sched& S, const Epi& E, const int tid) {
    const int wid = __builtin_amdgcn_readfirstlane(tid >> 6), lane = tid & 63, wr = wid >> 2, wc = wid & 3, fr = lane & 15, fq = lane >> 4;
    const int K = g.K, nt = K / BK;
    unsigned voffA[2], voffB[2];
#pragma unroll
    for (int i = 0; i < 2; ++i) { int R, C; stage_rc(tid * 16 + i * 8192, R, C); const int Rb = Epi::PERM ? ((R & ~31) + perm32(R & 31)) : R;
        voffA[i] = (unsigned)(R * g.lda + C) * 2u; voffB[i] = (unsigned)(Rb * 64 + C) * 2u; }
    const size_t kstep = (size_t)(BK * 2);
    const size_t hstepA = (size_t)HALF * g.lda * 2, hstepB = (size_t)HALF * 64 * 2;
    const size_t tstepA = 2 * hstepA, tstepB = 2 * hstepB;
    const size_t kstepA = g.kstepA, kstepB = (size_t)g.N * 128;
    const unsigned ldsw = (unsigned)wid * 1024u;
    const int aoff = lds_byte(wr * 64 + fr, fq * 8), boff = lds_byte(wc * 32 + fr, fq * 8);
#define PG8_SA(b, h) (((b) * 2 + (h)) * HTB)
#define PG8_SB(b, h) ((4 + (b) * 2 + (h)) * HTB)
#define PG8_STAGE(bufoff, gbase, voff) do { _Pragma("unroll") for (int _i = 0; _i < 2; ++_i) \
        __builtin_amdgcn_global_load_lds((const unsigned*)((const char*)(gbase) + (voff)[_i]), (LAS unsigned*)(lds + (bufoff) + ldsw + _i * 8192), 16, 0, 0); } while (0)
#define PG8_LDA(dst, b, h) do { _Pragma("unroll") for (int m = 0; m < 4; ++m) _Pragma("unroll") for (int k = 0; k < 2; ++k) dst[m][k] = *(const LAS bf16x8*)(lds + PG8_SA(b, h) + aoff + m * 2048 + k * 1024); } while (0)
#define PG8_LDB(dst, b, h) do { _Pragma("unroll") for (int n = 0; n < 2; ++n) _Pragma("unroll") for (int k = 0; k < 2; ++k) dst[n][k] = *(const LAS bf16x8*)(lds + PG8_SB(b, h) + boff + n * 2048 + k * 1024); } while (0)
#define PG8_MMA(ai, bj, At, Bt) do { __builtin_amdgcn_s_setprio(1); _Pragma("unroll") for (int m = 0; m < 4; ++m) _Pragma("unroll") for (int n = 0; n < 2; ++n) _Pragma("unroll") for (int k = 0; k < 2; ++k) \
        acc[ai][bj][m][n] = __builtin_amdgcn_mfma_f32_16x16x32_bf16(Bt[n][k], At[m][k], acc[ai][bj][m][n], 0, 0, 0); __builtin_amdgcn_s_setprio(0); } while (0)
#define PG8_WAIT_V(n) asm volatile("s_waitcnt vmcnt(" #n ")" ::: "memory")
#define PG8_WAIT_L(n) asm volatile("s_waitcnt lgkmcnt(" #n ")" ::: "memory")
#define PG8_BAR __builtin_amdgcn_s_barrier()
#define PG8_SCHED __builtin_amdgcn_sched_barrier(0)
    Unit cur, nxt; int ui = 0;
    if (!S.next(0, cur)) return;
    f32x4 acc[2][2][4][2];
#pragma unroll
    for (int a = 0; a < 2; ++a)
#pragma unroll
        for (int b = 0; b < 2; ++b)
#pragma unroll
            for (int m = 0; m < 4; ++m)
#pragma unroll
                for (int n = 0; n < 2; ++n) acc[a][b][m][n] = (f32x4){0.f, 0.f, 0.f, 0.f};
    bf16x8 At[4][2], B0[2][2], B1[2][2];
    const char* cA = (const char*)g.A + (size_t)cur.pm * tstepA; const char* cB = (const char*)g.Bt + (size_t)cur.pn * tstepB;
    if constexpr (SP2) {
        PG8_STAGE(PG8_SB(0, 0), cB, voffB); PG8_STAGE(PG8_SB(0, 1), cB + hstepB, voffB); PG8_STAGE(PG8_SA(0, 0), cA, voffA); PG8_STAGE(PG8_SA(0, 1), cA + hstepA, voffA);
        if (wr == 1) PG8_BAR;
        PG8_WAIT_V(2); PG8_BAR;
        PG8_STAGE(PG8_SB(1, 0), cB + kstepB, voffB); PG8_STAGE(PG8_SA(1, 0), cA + kstepA, voffA); PG8_STAGE(PG8_SB(1, 1), cB + hstepB + kstepB, voffB);
        PG8_WAIT_V(6); PG8_BAR;
    } else {
        PG8_STAGE(PG8_SB(0, 0), cB, voffB); PG8_STAGE(PG8_SA(0, 0), cA, voffA); PG8_STAGE(PG8_SB(0, 1), cB + hstepB, voffB); PG8_STAGE(PG8_SA(0, 1), cA + hstepA, voffA);
        if (wr == 1) PG8_BAR;
        PG8_WAIT_V(4); PG8_BAR;
        PG8_STAGE(PG8_SB(1, 0), cB + kstepB, voffB); PG8_STAGE(PG8_SA(1, 0), cA + kstepA, voffA); PG8_STAGE(PG8_SB(1, 1), cB + hstepB + kstepB, voffB);
        PG8_WAIT_V(6); PG8_BAR;
    }
    for (;;) {
        const bool has_next = S.next(ui + 1, nxt);
        const char* nA = has_next ? (const char*)g.A + (size_t)nxt.pm * tstepA : cA; const char* nB = has_next ? (const char*)g.Bt + (size_t)nxt.pn * tstepB : cB;
        for (int t = 0; t < nt; t += 2) {
            const bool last = (t == nt - 2);
            const char* a1 = cA + (size_t)(t + 1) * kstepA;
            const char* a2 = last ? nA : cA + (size_t)(t + 2) * kstepA; const char* b2 = last ? nB : cB + (size_t)(t + 2) * kstepB;
            const char* a3 = a2 + kstepA; const char* b3 = b2 + kstepB;
            if constexpr (SP2) {
            PG8_LDB(B0, 0, 0); PG8_LDB(B1, 0, 1); PG8_SCHED; PG8_LDA(At, 0, 0); PG8_STAGE(PG8_SA(1, 1), a1 + hstepA, voffA);
            PG8_WAIT_V(8); PG8_WAIT_L(0); PG8_BAR; PG8_MMA(0, 0, At, B0); PG8_MMA(0, 1, At, B1); PG8_BAR; PG8_SCHED;
            PG8_LDA(At, 0, 1); PG8_STAGE(PG8_SB(0, 0), b2, voffB); PG8_STAGE(PG8_SB(0, 1), b2 + hstepB, voffB); PG8_STAGE(PG8_SA(0, 0), a2, voffA);
            PG8_WAIT_V(8); PG8_WAIT_L(0); PG8_BAR; PG8_MMA(1, 0, At, B0); PG8_MMA(1, 1, At, B1); PG8_BAR; PG8_SCHED;
            PG8_LDB(B0, 1, 0); PG8_LDB(B1, 1, 1); PG8_SCHED; PG8_LDA(At, 1, 0); PG8_STAGE(PG8_SA(0, 1), a2 + hstepA, voffA);
            PG8_WAIT_V(8); PG8_WAIT_L(0); PG8_BAR; PG8_MMA(0, 0, At, B0); PG8_MMA(0, 1, At, B1); PG8_BAR; PG8_SCHED;
            PG8_LDA(At, 1, 1); PG8_STAGE(PG8_SB(1, 0), b3, voffB); PG8_STAGE(PG8_SB(1, 1), b3 + hstepB, voffB); PG8_STAGE(PG8_SA(1, 0), a3, voffA);
            PG8_WAIT_V(8); PG8_WAIT_L(0); PG8_BAR; PG8_MMA(1, 0, At, B0); PG8_MMA(1, 1, At, B1); PG8_BAR; PG8_SCHED;
            } else {
            PG8_LDB(B0, 0, 0); PG8_SCHED; PG8_LDA(At, 0, 0); PG8_STAGE(PG8_SA(1, 1), a1 + hstepA, voffA);
            PG8_WAIT_L(8); PG8_BAR; PG8_WAIT_L(0); PG8_MMA(0, 0, At, B0); PG8_BAR; PG8_SCHED;
            PG8_LDB(B1, 0, 1); PG8_STAGE(PG8_SB(0, 0), b2, voffB);
            PG8_BAR; PG8_WAIT_L(0); PG8_MMA(0, 1, At, B1); PG8_BAR;
            PG8_LDA(At, 0, 1); PG8_STAGE(PG8_SA(0, 0), a2, voffA);
            PG8_BAR; PG8_WAIT_L(0); PG8_MMA(1, 0, At, B0); PG8_BAR; PG8_SCHED;
            PG8_STAGE(PG8_SB(0, 1), b2 + hstepB, voffB);
            PG8_WAIT_V(6); PG8_BAR; PG8_MMA(1, 1, At, B1); PG8_BAR;
            PG8_LDB(B0, 1, 0); PG8_SCHED; PG8_LDA(At, 1, 0); PG8_STAGE(PG8_SA(0, 1), a2 + hstepA, voffA);
            PG8_WAIT_L(8); PG8_BAR; PG8_WAIT_L(0); PG8_MMA(0, 0, At, B0); PG8_BAR; PG8_SCHED;
            PG8_LDB(B1, 1, 1); PG8_STAGE(PG8_SB(1, 0), b3, voffB);
            PG8_BAR; PG8_WAIT_L(0); PG8_MMA(0, 1, At, B1); PG8_BAR;
            PG8_LDA(At, 1, 1); PG8_STAGE(PG8_SA(1, 0), a3, voffA);
            PG8_BAR; PG8_WAIT_L(0); PG8_MMA(1, 0, At, B0); PG8_BAR; PG8_SCHED;
            PG8_STAGE(PG8_SB(1, 1), b3 + hstepB, voffB);
            PG8_WAIT_V(6); PG8_BAR; PG8_MMA(1, 1, At, B1); PG8_BAR;
            }
        }
        if constexpr (ALIGN_EPI) { if (wr == 0) PG8_BAR; }
        E(acc, cur, wr, wc, fr, fq);
        if (!has_next) break;
#pragma unroll
        for (int a = 0; a < 2; ++a)
#pragma unroll
            for (int b = 0; b < 2; ++b)
#pragma unroll
                for (int m = 0; m < 4; ++m)
#pragma unroll
                    for (int n = 0; n < 2; ++n) acc[a][b][m][n] = (f32x4){0.f, 0.f, 0.f, 0.f};
        cur = nxt; cA = nA; cB = nB; ++ui;
        if constexpr (ALIGN_EPI) { if (wr == 1) PG8_BAR; }
    }
    PG8_WAIT_V(0);
    if constexpr (!ALIGN_EPI) { if (wr == 0) PG8_BAR; }
    PG8_BAR;
#undef PG8_SA
#undef PG8_SB
#undef PG8_STAGE
#undef PG8_LDA
#undef PG8_LDB
#undef PG8_MMA
#undef PG8_WAIT_V
#undef PG8_WAIT_L
#undef PG8_BAR
#undef PG8_SCHED
}
}

struct AttnP { const bf16_t* Q; int ldq, hsq; const bf16_t* K; int ldk, hsk; const bf16_t* V; int ldv, hsv; bf16_t* O; int ldo; const float* bias; const int* pos; const float* gq; const float* cs; const float* sn; };
__device__ __forceinline__ int crow(int r, int hi) { return (r & 3) + 8 * (r >> 2) + 4 * hi; }

template <int DQK, bool BAND>
__device__ __forceinline__ void attn_phase(LAS unsigned char* lds, const AttnP P, const int tid) {
    constexpr int SK = DQK * 2 + 16, SV = 320;
    constexpr int KBYTES = 64 * SK, VBYTES = 64 * SV, BUF = KBYTES + VBYTES;
    constexpr int OFF_KPOS = 2 * BUF, OFF_BIAS = OFF_KPOS + 512, OFF_KMAX = OFF_BIAS + 2112;
    constexpr int CPR = DQK / 8, NKC = 64 * CPR / 512, NDS = DQK / 16;
    const int lane = tid & 63, r32 = lane & 31, hi = lane >> 5;
    const int wid = __builtin_amdgcn_readfirstlane(tid >> 6);
    LAS int* kposL = (LAS int*)(lds + OFF_KPOS);
    LAS float* biasL = (LAS float*)(lds + OFF_BIAS);
    LAS int* kmaxL = (LAS int*)(lds + OFF_KMAX);
    constexpr int NUNITS = NB * NH * (SEQ / 256);
    for (int ui = blockIdx.x; ui < NUNITS; ui += gridDim.x) {
        const int jr = ui >> 8, vv = ui & 255, bh = vv >> 2, s4 = vv & 3;
        const int qb = (jr == 0) ? s4 : (jr == 1) ? 7 - s4 : (jr == 2) ? 8 + s4 : 15 - s4;
        const int b = bh / NH, h = bh % NH;
        const size_t rowbase = (size_t)b * SEQ; const int q0 = qb * 256;
        const int cw = 4 * qb + (wid >> 1);
        const int t_lo = BAND ? (4 * qb - 8 > 0 ? 4 * qb - 8 : 0) : 0, t_hi = 4 * qb + 3;
        const int w_lo = BAND ? (cw - 8 > 0 ? cw - 8 : 0) : 0, w_hi = cw;
        bf16x8 qf[NDS];
        { const bf16_t* qp = P.Q + (rowbase + q0 + wid * 32 + r32) * P.ldq + h * P.hsq + hi * 8;
#pragma unroll
          for (int ds = 0; ds < NDS; ++ds) qf[ds] = *(const bf16x8*)(qp + ds * 16); }
        {
            float ssq = 0.f;
#pragma unroll
            for (int ds = 0; ds < NDS; ++ds)
#pragma unroll
                for (int e = 0; e < 8; ++e) { const float v = bf2f((unsigned)(unsigned short)qf[ds][e]); ssq += v * v; }
            ssq += __shfl_xor(ssq, 32);
            const float rq = __builtin_amdgcn_rsqf(ssq * (1.0f / DQK) + EPS) * ((BAND ? 0.08838834764831845f : 0.07216878364870322f) * LOG2E);
            const size_t tok = rowbase + q0 + wid * 32 + r32;
#pragma unroll
            for (int ds = 0; ds < 8; ++ds) {
                const f32x4 g0 = *(const f32x4*)(P.gq + ds * 16 + hi * 8), g1 = *(const f32x4*)(P.gq + ds * 16 + hi * 8 + 4);
                u32x4 w;
                w.x = cvt_pk_bf16(bf2f((unsigned)(unsigned short)qf[ds][0]) * rq * g0[0], bf2f((unsigned)(unsigned short)qf[ds][1]) * rq * g0[1]);
                w.y = cvt_pk_bf16(bf2f((unsigned)(unsigned short)qf[ds][2]) * rq * g0[2], bf2f((unsigned)(unsigned short)qf[ds][3]) * rq * g0[3]);
                w.z = cvt_pk_bf16(bf2f((unsigned)(unsigned short)qf[ds][4]) * rq * g1[0], bf2f((unsigned)(unsigned short)qf[ds][5]) * rq * g1[1]);
                w.w = cvt_pk_bf16(bf2f((unsigned)(unsigned short)qf[ds][6]) * rq * g1[2], bf2f((unsigned)(unsigned short)qf[ds][7]) * rq * g1[3]);
                qf[ds] = __builtin_bit_cast(bf16x8, w);
            }
            if (!BAND)
#pragma unroll
            for (int j = 0; j < 2; ++j) {
                const int i0 = 16 * j + 8 * hi;
                float o1[8], o2[8];
                const f32x4 cA = *(const f32x4*)(P.cs + tok * 32 + i0), cB = *(const f32x4*)(P.cs + tok * 32 + i0 + 4), sA = *(const f32x4*)(P.sn + tok * 32 + i0), sB = *(const f32x4*)(P.sn + tok * 32 + i0 + 4);
                const f32x4 g1A = *(const f32x4*)(P.gq + 128 + i0), g1B = *(const f32x4*)(P.gq + 128 + i0 + 4), g2A = *(const f32x4*)(P.gq + 160 + i0), g2B = *(const f32x4*)(P.gq + 160 + i0 + 4);
#pragma unroll
                for (int e = 0; e < 8; ++e) {
                    const float c = e < 4 ? cA[e & 3] : cB[e & 3], sn_ = e < 4 ? sA[e & 3] : sB[e & 3];
                    const float x1 = bf2f((unsigned)(unsigned short)qf[8 + j][e]) * rq * (e < 4 ? g1A[e & 3] : g1B[e & 3]), x2 = bf2f((unsigned)(unsigned short)qf[10 + j][e]) * rq * (e < 4 ? g2A[e & 3] : g2B[e & 3]);
                    o1[e] = x1 * c - x2 * sn_; o2[e] = x2 * c + x1 * sn_;
                }
                u32x4 w1, w2;
                w1.x = cvt_pk_bf16(o1[0], o1[1]); w1.y = cvt_pk_bf16(o1[2], o1[3]); w1.z = cvt_pk_bf16(o1[4], o1[5]); w1.w = cvt_pk_bf16(o1[6], o1[7]);
                w2.x = cvt_pk_bf16(o2[0], o2[1]); w2.y = cvt_pk_bf16(o2[2], o2[3]); w2.z = cvt_pk_bf16(o2[4], o2[5]); w2.w = cvt_pk_bf16(o2[6], o2[7]);
                qf[8 + j] = __builtin_bit_cast(bf16x8, w1); qf[10 + j] = __builtin_bit_cast(bf16x8, w2);
            }
        }
        int qpos = 0;
        if (BAND) { for (int i = tid; i < 513; i += 512) biasL[i] = P.bias[h * 513 + i] * LOG2E; qpos = P.pos[rowbase + q0 + wid * 32 + r32]; }
        int qmin = qpos;
        if (BAND) {
#pragma unroll
            for (int o = 1; o < 64; o <<= 1) { const int t_ = __shfl_xor(qmin, o); qmin = t_ < qmin ? t_ : qmin; }
        }
        f32x16 o[4];
#pragma unroll
        for (int d = 0; d < 4; ++d)
#pragma unroll
            for (int r = 0; r < 16; ++r) o[d][r] = 0.f;
        float mrun = -1e30f, lrun = 0.f;
        u32x4 kreg[NKC], vreg[2]; int kpreg = 0;
        const bf16_t* Kh = P.K + rowbase * P.ldk + h * P.hsk; const bf16_t* Vh = P.V + rowbase * P.ldv + h * P.hsv;
        unsigned kgo[NKC], klo[NKC], vgo[2], vlo[2];
#pragma unroll
        for (int i = 0; i < NKC; ++i) { const int c = tid + i * 512, row = c / CPR, cc = c % CPR; kgo[i] = (unsigned)(row * P.ldk + cc * 8); klo[i] = (unsigned)(row * SK + cc * 16); }
#pragma unroll
        for (int i = 0; i < 2; ++i) { const int c = tid + i * 512, row = c >> 4, cc = c & 15; vgo[i] = (unsigned)(row * P.ldv + cc * 8); vlo[i] = (unsigned)(KBYTES + row * SV + cc * 16); }
#define ATT_BAR() do { asm volatile("s_waitcnt lgkmcnt(0)" ::: "memory"); __builtin_amdgcn_s_barrier(); asm volatile("" ::: "memory"); } while (0)
#define ATT_LOADK(t) do { const bf16_t* kt_ = Kh + (size_t)(t) * 64 * P.ldk; _Pragma("unroll") for (int i = 0; i < NKC; ++i) kreg[i] = *(const u32x4*)(kt_ + kgo[i]); } while (0)
#define ATT_LOADV(t) do { const bf16_t* vt_ = Vh + (size_t)(t) * 64 * P.ldv; _Pragma("unroll") for (int i = 0; i < 2; ++i) vreg[i] = *(const u32x4*)(vt_ + vgo[i]); \
        if (BAND) { if (tid < 64) kpreg = P.pos[rowbase + (t) * 64 + tid]; } } while (0)
#define ATT_STOREK(bufi) do { LAS unsigned char* kb_ = lds + (bufi) * BUF; _Pragma("unroll") for (int i = 0; i < NKC; ++i) *(LAS u32x4*)(kb_ + klo[i]) = kreg[i]; } while (0)
#define ATT_STOREV(bufi) do { LAS unsigned char* kb_ = lds + (bufi) * BUF; _Pragma("unroll") for (int i = 0; i < 2; ++i) *(LAS u32x4*)(kb_ + vlo[i]) = vreg[i]; \
        if (BAND) { if (tid < 64) { kposL[(bufi) * 64 + tid] = kpreg; int mx_ = kpreg; _Pragma("unroll") for (int o = 1; o < 64; o <<= 1) { const int t_ = __shfl_xor(mx_, o); mx_ = t_ > mx_ ? t_ : mx_; } if (tid == 0) kmaxL[(bufi)] = mx_; } } } while (0)
        ATT_LOADK(t_lo); ATT_LOADV(t_lo); ATT_STOREK(0); ATT_STOREV(0); __syncthreads();
        const int grp = wid >> 2;
        { const int t1 = t_lo < t_hi ? t_lo + 1 : t_hi; ATT_LOADK(t1); ATT_LOADV(t1); }
        if (grp == 1) ATT_BAR();
        for (int t = t_lo; t <= t_hi; ++t) {
            const int cur = (t - t_lo) & 1;
            const int tn = t + 2 < t_hi ? t + 2 : t_hi;
            const bool part = (t >= w_lo && t <= w_hi);
            const LAS unsigned char* Kb = lds + cur * BUF; const LAS unsigned char* Vb = Kb + KBYTES;
            f32x16 p0, p1;
            if (part) {
#pragma unroll
                for (int r = 0; r < 16; ++r) { p0[r] = 0.f; p1[r] = 0.f; }
#pragma unroll
                for (int ds = 0; ds < NDS; ++ds) {
                    const bf16x8 k0 = *(const LAS bf16x8*)(Kb + r32 * SK + ds * 32 + hi * 16);
                    const bf16x8 k1 = *(const LAS bf16x8*)(Kb + (32 + r32) * SK + ds * 32 + hi * 16);
                    p0 = __builtin_amdgcn_mfma_f32_32x32x16_bf16(k0, qf[ds], p0, 0, 0, 0);
                    p1 = __builtin_amdgcn_mfma_f32_32x32x16_bf16(k1, qf[ds], p1, 0, 0, 0);
                    if ((ds & 1) == 1) __builtin_amdgcn_sched_barrier(0);
                }
            }
            ATT_STOREK(cur ^ 1); ATT_LOADK(tn);
            ATT_BAR();
            if (part) {
                if (BAND && qmin - kmaxL[cur] >= 256) {
                    const float bc = biasL[512];
#pragma unroll
                    for (int r = 0; r < 16; ++r) { p0[r] += bc; p1[r] += bc; }
                } else if (BAND) {
#pragma unroll
                    for (int r = 0; r < 16; ++r) { const int key = crow(r, hi);
                        int r0 = qpos - kposL[cur * 64 + key], r1 = qpos - kposL[cur * 64 + 32 + key];
                        r0 = (r0 < -256 ? -256 : (r0 > 256 ? 256 : r0)) + 256; r1 = (r1 < -256 ? -256 : (r1 > 256 ? 256 : r1)) + 256;
                        p0[r] += biasL[r0]; p1[r] += biasL[r1]; }
                }
                float mx = p0[0];
#pragma unroll
                for (int r = 1; r < 16; ++r) mx = fmaxf(mx, p0[r]);
#pragma unroll
                for (int r = 0; r < 16; ++r) mx = fmaxf(mx, p1[r]);
                mx = fmaxf(mx, __shfl_xor(mx, 32));
                if (__any(mx > mrun + 6.0f)) {
                    const float mnew = fmaxf(mrun, mx), alpha = __builtin_amdgcn_exp2f(mrun - mnew); mrun = mnew;
                    lrun *= alpha;
#pragma unroll
                    for (int d = 0; d < 4; ++d)
#pragma unroll
                        for (int r = 0; r < 16; ++r) o[d][r] *= alpha;
                }
                float ls = 0.f;
#pragma unroll
                for (int r = 0; r < 16; ++r) { p0[r] = __builtin_amdgcn_exp2f(p0[r] - mrun); p1[r] = __builtin_amdgcn_exp2f(p1[r] - mrun); ls += p0[r] + p1[r]; }
                lrun += ls;
                const LAS unsigned char* vbase = Vb + (4 * hi + ((lane & 15) >> 2)) * SV + (16 * ((lane >> 4) & 1) + 4 * (lane & 3)) * 2;
#pragma unroll
                for (int kb = 0; kb < 2; ++kb)
#pragma unroll
                    for (int s = 0; s < 2; ++s) {
                        u32x4 pw;
                        if (kb == 0) { pw.x = cvt_pk_bf16(p0[8 * s + 0], p0[8 * s + 1]); pw.y = cvt_pk_bf16(p0[8 * s + 2], p0[8 * s + 3]); pw.z = cvt_pk_bf16(p0[8 * s + 4], p0[8 * s + 5]); pw.w = cvt_pk_bf16(p0[8 * s + 6], p0[8 * s + 7]); }
                        else         { pw.x = cvt_pk_bf16(p1[8 * s + 0], p1[8 * s + 1]); pw.y = cvt_pk_bf16(p1[8 * s + 2], p1[8 * s + 3]); pw.z = cvt_pk_bf16(p1[8 * s + 4], p1[8 * s + 5]); pw.w = cvt_pk_bf16(p1[8 * s + 6], p1[8 * s + 7]); }
                        const bf16x8 pb = __builtin_bit_cast(bf16x8, pw);
#pragma unroll
                        for (int d = 0; d < 4; ++d) {
                            const LAS unsigned char* ap = vbase + (32 * kb + 16 * s) * SV + d * 64;
                            const s16x4 lo = __builtin_bit_cast(s16x4, __builtin_amdgcn_ds_read_tr16_b64_v4i16((LAS s16x4*)ap));
                            const s16x4 h4 = __builtin_bit_cast(s16x4, __builtin_amdgcn_ds_read_tr16_b64_v4i16((LAS s16x4*)(ap + 8 * SV)));
                            const bf16x8 va = (bf16x8){lo[0], lo[1], lo[2], lo[3], h4[0], h4[1], h4[2], h4[3]};
                            o[d] = __builtin_amdgcn_mfma_f32_32x32x16_bf16(va, pb, o[d], 0, 0, 0);
                        }
                        __builtin_amdgcn_sched_barrier(0);
                    }
            }
            ATT_STOREV(cur ^ 1); ATT_LOADV(tn);
            ATT_BAR();
        }
        if (grp == 0) ATT_BAR();
#undef ATT_BAR
#undef ATT_LOADK
#undef ATT_LOADV
#undef ATT_STOREK
#undef ATT_STOREV
        const float ltot = lrun + __shfl_xor(lrun, 32), inv = 1.0f / ltot;
        bf16_t* op = P.O + (rowbase + q0 + wid * 32 + r32) * P.ldo + h * 128 + 4 * hi;
#pragma unroll
        for (int d = 0; d < 4; ++d)
#pragma unroll
            for (int g4 = 0; g4 < 4; ++g4) {
                u32x2 w; w.x = cvt_pk_bf16(o[d][4 * g4 + 0] * inv, o[d][4 * g4 + 1] * inv); w.y = cvt_pk_bf16(o[d][4 * g4 + 2] * inv, o[d][4 * g4 + 3] * inv);
                *(u32x2*)(op + 32 * d + 8 * g4) = w;
            }
    }
}

constexpr size_t MiB = 1u << 20;
constexpr size_t WS_W1 = 1 * MiB, WS_WUQ = 6 * MiB, WS_WUKV = 9 * MiB, WS_WOA = 13 * MiB, WS_WGU0 = 21 * MiB, WS_WGU1 = 65 * MiB, WS_WD0 = 109 * MiB, WS_WD1 = 131 * MiB,
                 WS_WEG0 = 153 * MiB, WS_WEG1 = 161 * MiB, WS_WEP0 = 169 * MiB, WS_WEP1 = 170 * MiB, WS_WSKVQ = 171 * MiB, WS_WOB = 195 * MiB;
constexpr size_t WS_PBF = 203 * MiB;
constexpr size_t WS_A = 219 * MiB;
constexpr size_t WS_PP = 283 * MiB;
constexpr size_t WS_RAW1 = 347 * MiB;
constexpr size_t WS_KA = 387 * MiB;
constexpr size_t WS_CQN = 387 * MiB, WS_CKVN = 403 * MiB;
constexpr size_t WS_H = 347 * MiB;
constexpr size_t WS_RAW3 = 219 * MiB;
constexpr size_t WS_AB = 475 * MiB;
constexpr size_t WS_OB = 411 * MiB;
constexpr size_t WS_SS = 65536;
constexpr size_t WS_ROPE = 500 * MiB;
constexpr size_t WS_END = 539 * MiB;
constexpr int LDS_BYTES = 135168;
constexpr int NPHASE = 22;
constexpr int REP_P0 = 1, REP_P5 = 1, REP_P7 = 1, REP_P15 = 1, EXTRA_SYNCS = 0;
#define PROBE_DUP8 0
#define PROBE_DUP13 0
#define PROBE_DUP6 0
#define PROBE_DUP1 0
#define PROBE_DUP3 0

#define XB_TMO      128
#define XB_XCNT(j)  (256  + 64 * (j))
#define XB_XSUB(j)  (1280 + 64 * (j))
#define XB_XGEN(j)  (2304 + 64 * (j))
#define XB_TOP      3328
#define XB_TOPGEN   3392
#define XCD_BAR_WORDS 3456
#define XB_SPIN_CAP (1u << 18)

__device__ __forceinline__ unsigned xb_ld(unsigned* p)              { return __hip_atomic_load(p, __ATOMIC_RELAXED, __HIP_MEMORY_SCOPE_AGENT); }
__device__ __forceinline__ unsigned xb_add(unsigned* p, unsigned v) { return __hip_atomic_fetch_add(p, v, __ATOMIC_RELAXED, __HIP_MEMORY_SCOPE_AGENT); }
__device__ __forceinline__ unsigned xb_xcc_id() { return (unsigned)__builtin_amdgcn_s_getreg((3 << 11) | 20) & 0xFu; }
#define XB_SPIN(cond, bar) do { unsigned _sp = 0; while (cond) { __builtin_amdgcn_s_sleep(1); \
    if ((++_sp & 255u) == 0u) { if (xb_ld(&(bar)[XB_TMO])) break; if (_sp > XB_SPIN_CAP) { atomicAdd(&(bar)[XB_TMO], 1u); break; } } } } while (0)

struct XcdBarrier {
    unsigned* bar; unsigned x;
    volatile LAS unsigned* st;
};

__device__ __forceinline__ XcdBarrier xcd_barrier_post(unsigned* bar, volatile LAS unsigned* st) {
    XcdBarrier b; b.bar = bar; b.x = xb_xcc_id(); b.st = st;
    if (threadIdx.x == 0) (void)xb_add(&bar[XB_XCNT(b.x)], 1u);
    return b;
}
__device__ __forceinline__ void xcd_barrier_complete(unsigned* bar, unsigned x, unsigned& nloc, unsigned& nx) {
    const unsigned G = gridDim.x * gridDim.y * gridDim.z;
    unsigned sum, cnt, mine, sp = 0u;
    for (;;) {
        sum = 0u; cnt = 0u; mine = 0u;
#pragma unroll
        for (unsigned j = 0; j < 16; ++j) { const unsigned c = xb_ld(&bar[XB_XCNT(j)]); sum += c; cnt += (c > 0u) ? 1u : 0u; mine = (j == x) ? c : mine; }
        if (sum == G) break;
        __builtin_amdgcn_s_sleep(1);
        if ((++sp & 255u) == 0u) { if (xb_ld(&bar[XB_TMO])) break; if (sp > XB_SPIN_CAP) { atomicAdd(&bar[XB_TMO], 1u); break; } }
    }
    nloc = mine > 0u ? mine : 1u; nx = cnt > 0u ? cnt : 1u;
}

__device__ __forceinline__ void xcd_barrier(const XcdBarrier& b) {
    asm volatile("s_waitcnt vmcnt(0)" ::: "memory");
    __syncthreads();
    if (threadIdx.x == 0) {
        unsigned* bar = b.bar;
        __builtin_amdgcn_s_waitcnt(0);
        unsigned nloc = b.st[0], nx = b.st[1];
        if (nloc == 0u) { xcd_barrier_complete(bar, b.x, nloc, nx); b.st[0] = nloc; b.st[1] = nx; }
        const unsigned old = xb_add(&bar[XB_XSUB(b.x)], 1u);
        const unsigned gen = old / nloc;
        if (old + 1u == (gen + 1u) * nloc) {
            __builtin_amdgcn_fence(__ATOMIC_RELEASE, "agent");
            asm volatile("s_waitcnt vmcnt(0)" ::: "memory");
            const unsigned og = xb_add(&bar[XB_TOP], 1u);
            const unsigned tg = og / nx;
            if (og + 1u == (tg + 1u) * nx) xb_add(&bar[XB_TOPGEN], 1u);
            else XB_SPIN(xb_ld(&bar[XB_TOPGEN]) == tg, bar);
            __builtin_amdgcn_fence(__ATOMIC_ACQUIRE, "agent");
            xb_add(&bar[XB_XGEN(b.x)], 1u);
            asm volatile("s_waitcnt vmcnt(0)" ::: "memory");
        } else {
            XB_SPIN(xb_ld(&bar[XB_XGEN(b.x)]) == gen, bar);
            __builtin_amdgcn_fence(__ATOMIC_ACQUIRE, "agent");
            asm volatile("s_waitcnt vmcnt(0)" ::: "memory");
        }
    }
    __syncthreads();
}


constexpr size_t WS_BAR = 16384;
constexpr int LDS_MISC = 131072 + 64;

struct Args { const void* in[29]; float* out; unsigned char* ws; int ph_lo, ph_hi; };

__device__ __forceinline__ void tr_item(const float* W, int N, const float* g, bf16_t* WT, int ldk, int drow, int k0, int n0, LAS float* scr, int lane) {
    float v[32];
    const float* wp = W + (size_t)(k0 + (lane >> 5)) * N + n0 + (lane & 31);
#pragma unroll
    for (int i = 0; i < 32; ++i) v[i] = __builtin_nontemporal_load(wp + (size_t)(2 * i) * N);
    if (g) {
#pragma unroll
        for (int i = 0; i < 32; ++i) v[i] *= g[k0 + 2 * i + (lane >> 5)];
    }
#pragma unroll
    for (int i = 0; i < 32; ++i) scr[(2 * i + (lane >> 5)) * 33 + (lane & 31)] = v[i];
    asm volatile("s_waitcnt lgkmcnt(0)" ::: "memory");
    const int c = lane & 7;
#pragma unroll
    for (int j = 0; j < 4; ++j) { const int n = (lane >> 3) + 8 * j; const LAS float* s = scr + (8 * c) * 33 + n;
        u32x4 o; o.x = cvt_pk_bf16(s[0 * 33], s[1 * 33]); o.y = cvt_pk_bf16(s[2 * 33], s[3 * 33]); o.z = cvt_pk_bf16(s[4 * 33], s[5 * 33]); o.w = cvt_pk_bf16(s[6 * 33], s[7 * 33]);
        *(u32x4*)(WT + ((size_t)(k0 >> 6) * ldk + drow + n) * 64 + 8 * c) = o; }
    asm volatile("s_waitcnt lgkmcnt(0)" ::: "memory");
}
template <int KIND>
__device__ __forceinline__ void conv_matrix(const float* W, int K, int N, const float* g, bf16_t* WT, int NR, int row_off, int gw, int NGW, LAS float* scr, int lane) {
    const int nblk = N / 32, nitems = (K / 64) * nblk;
    for (int it = gw; it < nitems; it += NGW) { const int kb = it / nblk, nb = it % nblk, n0 = 32 * nb;
        const int drow = KIND == 0 ? row_off + n0 : ((n0 >> 7) * 256 + row_off * 128 + (n0 & 127));
        tr_item(W, N, g, WT, NR, drow, 64 * kb, n0, scr, lane); }
}
__device__ __forceinline__ void rms_row(const float* xrow, bf16_t* orow, int lane) {
    const f32x4* xr = (const f32x4*)xrow + lane;
    f32x4 v[8]; float s = 0.f;
#pragma unroll
    for (int j = 0; j < 8; ++j) { v[j] = xr[64 * j]; s += (v[j].x * v[j].x + v[j].y * v[j].y) + (v[j].z * v[j].z + v[j].w * v[j].w); }
    const float rstd = __builtin_amdgcn_rsqf(wave_sum(s) * (1.0f / D) + EPS);
    u32x2* o8 = (u32x2*)orow + lane;
#pragma unroll
    for (int j = 0; j < 8; ++j) { u32x2 w; w.x = cvt_pk_bf16(v[j].x * rstd, v[j].y * rstd); w.y = cvt_pk_bf16(v[j].z * rstd, v[j].w * rstd); o8[64 * j] = w; }
}

#define PH_BEGIN(k) if (ph_lo <= (k) && (k) < ph_hi) { \
        int tid = wave_s * 64 + (int)__builtin_amdgcn_mbcnt_hi(~0u, __builtin_amdgcn_mbcnt_lo(~0u, 0u)); asm volatile("" : "+v"(tid)); \
        const __attribute__((address_space(4))) Args* ap = (const __attribute__((address_space(4))) Args*)__builtin_amdgcn_kernarg_segment_ptr(); asm volatile("" : "+s"(ap)); \
        const int lane = tid & 63, wave = __builtin_amdgcn_readfirstlane(tid >> 6), gw = blockIdx.x * 8 + wave, NGW = G * 8; \
        unsigned char* ws = ap->ws; float* out = ap->out; \
        const float* x = (const float*)ap->in[0]; const float* pin = (const float*)ap->in[1]; const int* positions = (const int*)ap->in[2]; \
        bf16_t* A = (bf16_t*)(ws + WS_A); bf16_t* PP = (bf16_t*)(ws + WS_PP); bf16_t* PBF = (bf16_t*)(ws + WS_PBF); \
        bf16_t* RAW1 = (bf16_t*)(ws + WS_RAW1); bf16_t* KA = (bf16_t*)(ws + WS_KA); bf16_t* CQN = (bf16_t*)(ws + WS_CQN); bf16_t* CKVN = (bf16_t*)(ws + WS_CKVN); \
        bf16_t* HB = (bf16_t*)(ws + WS_H); bf16_t* RAW3 = (bf16_t*)(ws + WS_RAW3); \
        bf16_t* QA = (bf16_t*)out; bf16_t* VA = A; bf16_t* KN = PP; bf16_t* OA = PP; bf16_t* OB = (bf16_t*)(ws + WS_OB); bf16_t* AB = (bf16_t*)(ws + WS_AB); float* SS = (float*)(ws + WS_SS); \
        (void)lane; (void)wave; (void)gw; (void)NGW; (void)x; (void)pin; (void)positions; (void)PBF; (void)RAW1; (void)KA; (void)CQN; (void)CKVN; (void)HB; (void)RAW3; (void)QA; (void)VA; (void)KN; (void)OA; (void)OB; (void)AB; (void)SS;
#define PH_END(k) if ((k) + 1 < ph_hi) { if (ph_hi > NPHASE) grid.sync(); else xcd_barrier(xbar); } }
#define GEMM_B(MODE, Aptr, Bptr, Nv, Kv, O0v, O1v, ldcv, ssin) do { pg8::Gemm g{Aptr, (const bf16_t*)(Bptr), M, Nv, Kv, Kv, (size_t)128}; pg8::StaticOrder So; So.init(M, Nv, G, (int)blockIdx.x); \
        pg8::EpiB<MODE> E{O0v, O1v, ldcv, ssin}; pg8::gemm_phase<pg8::EpiB<MODE>, pg8::StaticOrder, true, true>(lds, g, So, E, tid); } while (0)
#define GEMM_BX(MODE, ALIGN, Aptr, Bptr, Nv, Kv, O0v, O1v, ldcv, ssin) do { pg8::Gemm g{Aptr, (const bf16_t*)(Bptr), M, Nv, Kv, Kv, (size_t)128}; pg8::StaticOrder So; So.init(M, Nv, G, (int)blockIdx.x); \
        pg8::EpiB<MODE> E{O0v, O1v, ldcv, ssin}; pg8::gemm_phase<pg8::EpiB<MODE>, pg8::StaticOrder, ALIGN, true>(lds, g, So, E, tid); } while (0)
#define GEMM_R(MODE, BASE, Aptr, Bptr, Kv, basefv, basebv, outv, ppv, xbv, ssoutv, ssinv, ldav, kstepv, revv) do { pg8::Gemm g{Aptr, (const bf16_t*)(Bptr), M, D, Kv, ldav, kstepv}; pg8::StaticOrder So; So.init(M, D, G, (int)blockIdx.x, revv); \
        pg8::EpiF<MODE, BASE> E{basefv, basebv, outv, ppv, D, xbv, ssoutv, ssinv}; pg8::gemm_phase<pg8::EpiF<MODE, BASE>, pg8::StaticOrder, true, true>(lds, g, So, E, tid); } while (0)
#define NORM_PASS() do { for (int m = gw; m < M; m += NGW) rms_row(out + (size_t)m * D, A + (size_t)m * D, lane); } while (0)

__global__ void __launch_bounds__(512, 2) yoco_fwd(Args args) {
    extern __shared__ __attribute__((aligned(16))) unsigned char lds_raw[];
    LAS unsigned char* lds = (LAS unsigned char*)lds_raw;
    cg::grid_group grid = cg::this_grid();
    const int G = gridDim.x, ph_lo = args.ph_lo, ph_hi = args.ph_hi;
    const int wave_s = __builtin_amdgcn_readfirstlane(threadIdx.x >> 6);
    if (threadIdx.x < 2) ((volatile LAS unsigned*)(lds + LDS_MISC))[threadIdx.x] = 0u;
    __syncthreads();
    XcdBarrier xbar = xcd_barrier_post((unsigned*)(args.ws + WS_BAR), (volatile LAS unsigned*)(lds + LDS_MISC));

    PH_BEGIN(0)
        for (int i = blockIdx.x * 512 + tid; i < 5 * M; i += G * 512) SS[i] = 0.f;
        for (int rep = 0; rep < REP_P0; ++rep) { if (rep) grid.sync();
            LAS float* scr = (LAS float*)(lds + wave * 16384);
            const float* a_norm = (const float*)ap->in[3];
            conv_matrix<0>((const float*)ap->in[4], D, 512, a_norm, (bf16_t*)(ws + WS_W1), N1P, 0, gw, NGW, scr, lane);
            conv_matrix<0>((const float*)ap->in[7], D, 576, a_norm, (bf16_t*)(ws + WS_W1), N1P, 512, gw, NGW, scr, lane);
            { const int per = 192 * 64 * 2 / 16, nz = (D / 64) * per; for (int i = blockIdx.x * 512 + tid; i < nz; i += G * 512) { const int kt = i / per, j = i % per; ((u32x4*)((bf16_t*)(ws + WS_W1) + ((size_t)kt * N1P + 1088) * 64))[j] = (u32x4){0u, 0u, 0u, 0u}; } }
            conv_matrix<0>((const float*)ap->in[6], 512, 3072, (const float*)ap->in[5], (bf16_t*)(ws + WS_WUQ), 3072, 0, gw, NGW, scr, lane);
            conv_matrix<0>((const float*)ap->in[9], 512, 4096, (const float*)ap->in[8], (bf16_t*)(ws + WS_WUKV), 4096, 0, gw, NGW, scr, lane);
            conv_matrix<0>((const float*)ap->in[12], D, D, nullptr, (bf16_t*)(ws + WS_WOA), D, 0, gw, NGW, scr, lane);
            conv_matrix<0>((const float*)ap->in[14], D, D, (const float*)ap->in[13], (bf16_t*)(ws + WS_WSKVQ), 6144, 0, gw, NGW, scr, lane);
            conv_matrix<0>((const float*)ap->in[15], D, D, (const float*)ap->in[13], (bf16_t*)(ws + WS_WSKVQ), 6144, 2048, gw, NGW, scr, lane);
            conv_matrix<0>((const float*)ap->in[18], D, D, (const float*)ap->in[17], (bf16_t*)(ws + WS_WSKVQ), 6144, 4096, gw, NGW, scr, lane);
            conv_matrix<0>((const float*)ap->in[21], D, D, nullptr, (bf16_t*)(ws + WS_WOB), D, 0, gw, NGW, scr, lane);
            for (int l = 0; l < 2; ++l) {
                const float* fn = (const float*)ap->in[22] + l * D; const float* en = (const float*)ap->in[26] + l * D;
                bf16_t* wgu = (bf16_t*)(ws + (l ? WS_WGU1 : WS_WGU0));
                if (l == 0 || G <= 64) conv_matrix<1>((const float*)ap->in[23] + (size_t)l * D * FF, D, FF, fn, wgu, 2 * FF, 0, gw, NGW, scr, lane);
                if (l == 0 || G <= 64) conv_matrix<1>((const float*)ap->in[24] + (size_t)l * D * FF, D, FF, fn, wgu, 2 * FF, 1, gw, NGW, scr, lane);
                if (l == 0 || (G & 3) != 0) conv_matrix<0>((const float*)ap->in[25] + (size_t)l * FF * D, FF, D, nullptr, (bf16_t*)(ws + (l ? WS_WD1 : WS_WD0)), D, 0, gw, NGW, scr, lane);
                conv_matrix<0>((const float*)ap->in[27] + (size_t)l * D * D, D, D, en, (bf16_t*)(ws + (l ? WS_WEG1 : WS_WEG0)), D, 0, gw, NGW, scr, lane);
                conv_matrix<0>((const float*)ap->in[28] + (size_t)l * PLE * D, PLE, D, nullptr, (bf16_t*)(ws + (l ? WS_WEP1 : WS_WEP0)), D, 0, gw, NGW, scr, lane);
            }
            if (G <= 64) { const int n4 = 2 * M * PLE / 4; const f32x4* p4 = (const f32x4*)pin; u32x2* o2 = (u32x2*)PBF;
              for (int i = blockIdx.x * 512 + tid; i < n4; i += G * 512) { const f32x4 v = p4[i]; u32x2 w; w.x = cvt_pk_bf16(v.x, v.y); w.y = cvt_pk_bf16(v.z, v.w); o2[i] = w; } }
            for (int m = gw; m < M; m += NGW) rms_row(x + (size_t)m * D, A + (size_t)m * D, lane);
        }
    PH_END(0)
    PH_BEGIN(1) GEMM_B(0, A, ws + WS_W1, N1P, D, RAW1, nullptr, N1P, nullptr);
        if (G > 64 && (int)blockIdx.x >= 64) {
            LAS float* scr = (LAS float*)(lds + wave * 16384);
            const float* fn1 = (const float*)ap->in[22] + D; bf16_t* wgu1 = (bf16_t*)(ws + WS_WGU1);
            const int gw1 = ((int)blockIdx.x - 64) * 8 + wave, NGW1 = (G - 64) * 8;
            conv_matrix<1>((const float*)ap->in[23] + (size_t)D * FF, D, FF, fn1, wgu1, 2 * FF, 0, gw1, NGW1, scr, lane);
            conv_matrix<1>((const float*)ap->in[24] + (size_t)D * FF, D, FF, fn1, wgu1, 2 * FF, 1, gw1, NGW1, scr, lane);
            { const int n4 = 2 * M * PLE / 4; const f32x4* p4 = (const f32x4*)pin; u32x2* o2 = (u32x2*)PBF;
              for (int i = ((int)blockIdx.x - 64) * 512 + tid; i < n4; i += (G - 64) * 512) { const f32x4 v = p4[i]; u32x2 w; w.x = cvt_pk_bf16(v.x, v.y); w.y = cvt_pk_bf16(v.z, v.w); o2[i] = w; } }
        }
    PH_END(1)
#if PROBE_DUP1
    PH_BEGIN(1) GEMM_B(0, A, ws + WS_W1, N1P, D, RAW1, nullptr, N1P, nullptr); PH_END(1)
#endif
    PH_BEGIN(2)
            for (int m0 = gw * 4; m0 < M; m0 += NGW * 4) {
                u32x4 v[4][2];
#pragma unroll
                for (int r = 0; r < 4; ++r)
#pragma unroll
                    for (int part = 0; part < 2; ++part) v[r][part] = *(const u32x4*)(RAW1 + (size_t)(m0 + r) * N1P + part * 512 + lane * 8);
#pragma unroll
                for (int r = 0; r < 4; ++r)
#pragma unroll
                    for (int part = 0; part < 2; ++part) {
                        const u32x4 q = v[r][part];
                        const float f0 = bflo(q.x), f1 = bfhi(q.x), f2 = bflo(q.y), f3 = bfhi(q.y), f4 = bflo(q.z), f5 = bfhi(q.z), f6 = bflo(q.w), f7 = bfhi(q.w);
                        const float sq = (f0 * f0 + f1 * f1) + (f2 * f2 + f3 * f3) + (f4 * f4 + f5 * f5) + (f6 * f6 + f7 * f7);
                        const float rstd = __builtin_amdgcn_rsqf(wave_sum(sq) * (1.0f / 512) + EPS);
                        u32x4 w; w.x = cvt_pk_bf16(f0 * rstd, f1 * rstd); w.y = cvt_pk_bf16(f2 * rstd, f3 * rstd); w.z = cvt_pk_bf16(f4 * rstd, f5 * rstd); w.w = cvt_pk_bf16(f6 * rstd, f7 * rstd);
                        *(u32x4*)((part ? CKVN : CQN) + (size_t)(m0 + r) * 512 + lane * 8) = w;
                    }
            }
    PH_END(2)
    PH_BEGIN(3) GEMM_B(0, CQN, ws + WS_WUQ, 3072, 512, QA, nullptr, 3072, nullptr); GEMM_B(1, CKVN, ws + WS_WUKV, 4096, 512, KN, VA, 2048, nullptr); PH_END(3)
#if PROBE_DUP3
    PH_BEGIN(3) GEMM_B(0, CQN, ws + WS_WUQ, 3072, 512, QA, nullptr, 3072, nullptr); GEMM_B(1, CKVN, ws + WS_WUKV, 4096, 512, KN, VA, 2048, nullptr); PH_END(3)
#endif
    PH_BEGIN(4)
            const float* g_kn = (const float*)ap->in[11];
            const float gk0 = g_kn[lane], gk1 = g_kn[64 + lane], gk2 = g_kn[128 + lane];
            const float invf = exp2f(-(float)(lane & 31) * (13.287712379549449f / 32.0f));
            const float sgn = (lane < 32) ? -1.0f : 1.0f;
            float* CSt = (float*)(ws + WS_ROPE); float* SNt = CSt + (size_t)M * 32;
            for (int m = gw; m < M; m += NGW) {
                const bf16_t* knrow = KN + (size_t)m * 2048; bf16_t* krow = KA + (size_t)m * 3072;
                unsigned short ka[NH], kb[NH];
#pragma unroll
                for (int h = 0; h < NH; ++h) { ka[h] = knrow[h * 128 + lane]; kb[h] = knrow[h * 128 + 64 + lane]; }
                const float kpe = bf2f(RAW1[(size_t)m * N1P + 1024 + lane]);
                const float ang = (float)positions[m] * invf;
                const double red = (double)ang - 6.283185307179586 * rint((double)ang * 0.15915494309189535);
                const float cs = cosf((float)red), sn = sinf((float)red);
                if (lane < 32) { CSt[(size_t)m * 32 + lane] = cs; SNt[(size_t)m * 32 + lane] = sn; }
#pragma unroll
                for (int h = 0; h < NH; ++h) {
                    float a = bf2f(ka[h]), b = bf2f(kb[h]), c = kpe;
                    const float rstd = __builtin_amdgcn_rsqf(wave_sum(a * a + b * b + c * c) * (1.0f / 192) + EPS);
                    a *= rstd * gk0; b *= rstd * gk1; c *= rstd * gk2;
                    const float pr = __shfl_xor(c, 32); c = c * cs + sgn * pr * sn;
                    krow[h * 192 + lane] = (bf16_t)(cvt_pk_bf16(a, 0.f) & 0xffffu); krow[h * 192 + 64 + lane] = (bf16_t)(cvt_pk_bf16(b, 0.f) & 0xffffu); krow[h * 192 + 128 + lane] = (bf16_t)(cvt_pk_bf16(c, 0.f) & 0xffffu);
                }
            }
    PH_END(4)
    PH_BEGIN(5) { AttnP P{QA, 3072, 192, KA, 3072, 192, VA, 2048, 128, OA, 2048, nullptr, positions, (const float*)ap->in[10], (const float*)(ws + WS_ROPE), (const float*)(ws + WS_ROPE) + (size_t)M * 32}; for (int rep = 0; rep < REP_P5; ++rep) { if (rep) grid.sync(); attn_phase<192, false>(lds, P, tid); } } PH_END(5)
    PH_BEGIN(6) GEMM_R(0, 0, OA, ws + WS_WOA, D, x, nullptr, nullptr, nullptr, A, SS, nullptr, D, (size_t)128, 0); PH_END(6)
    PH_BEGIN(8) GEMM_B(2, A, ws + WS_WGU0, 2 * FF, D, HB, nullptr, FF, SS); PH_END(8)
#if PROBE_DUP8
    PH_BEGIN(8) GEMM_B(2, A, ws + WS_WGU0, 2 * FF, D, HB, nullptr, FF, SS); PH_END(8)
#endif
    PH_BEGIN(9) GEMM_R(0, 1, HB, ws + WS_WD0, FF, nullptr, A, nullptr, nullptr, A, SS + M, nullptr, 64, (size_t)M * 128, 0); GEMM_B(0, PBF, ws + WS_WEP0, D, PLE, PP, nullptr, D, nullptr); PH_END(9)
    PH_BEGIN(11) GEMM_R(1, 1, A, ws + WS_WEG0, D, nullptr, A, nullptr, PP, AB, SS + 2 * M, SS + M, D, (size_t)128, 0); PH_END(11)
    PH_BEGIN(13) GEMM_B(0, AB, ws + WS_WSKVQ, 6144, D, RAW3, nullptr, 6144, SS + 2 * M); PH_END(13)
#if PROBE_DUP13
    PH_BEGIN(13) GEMM_B(0, AB, ws + WS_WSKVQ, 6144, D, RAW3, nullptr, 6144, SS + 2 * M); PH_END(13)
#endif
    PH_BEGIN(14)
            const float* gk = (const float*)ap->in[16];
            const float gk0 = gk[2 * lane], gk1 = gk[2 * lane + 1];
            for (int m = gw; m < M; m += NGW) {
                unsigned* row = (unsigned*)(RAW3 + (size_t)m * 6144);
                unsigned kw[NH];
#pragma unroll
                for (int h = 0; h < NH; ++h) kw[h] = row[h * 64 + lane];
#pragma unroll
                for (int h = 0; h < NH; ++h) {
                    const float a = bflo(kw[h]), b = bfhi(kw[h]);
                    const float rstd = __builtin_amdgcn_rsqf(wave_sum(a * a + b * b) * (1.0f / 128) + EPS);
                    row[h * 64 + lane] = cvt_pk_bf16(a * rstd * gk0, b * rstd * gk1);
                }
            }
    PH_END(14)
    PH_BEGIN(15) { AttnP P{RAW3 + 4096, 6144, 128, RAW3, 6144, 128, RAW3 + 2048, 6144, 128, OB, 2048, (const float*)ap->in[20], positions, (const float*)ap->in[19], nullptr, nullptr}; for (int rep = 0; rep < REP_P15; ++rep) { if (rep) grid.sync(); attn_phase<128, true>(lds, P, tid); } }
        if ((G & 3) == 0 && ((int)blockIdx.x & 3) < 2) {
            __syncthreads();
            LAS float* scr = (LAS float*)(lds + wave * 16384);
            const int j3 = ((int)blockIdx.x >> 2) * 3, NGW1 = (G >> 2) * 3 * 8;
            if (((int)blockIdx.x & 3) == 0) { conv_matrix<0>((const float*)ap->in[25] + (size_t)FF * D, FF, D, nullptr, (bf16_t*)(ws + WS_WD1), D, 0, j3 * 8 + wave, NGW1, scr, lane);
                                              conv_matrix<0>((const float*)ap->in[25] + (size_t)FF * D, FF, D, nullptr, (bf16_t*)(ws + WS_WD1), D, 0, (j3 + 1) * 8 + wave, NGW1, scr, lane); }
            else conv_matrix<0>((const float*)ap->in[25] + (size_t)FF * D, FF, D, nullptr, (bf16_t*)(ws + WS_WD1), D, 0, (j3 + 2) * 8 + wave, NGW1, scr, lane);
        }
    PH_END(15)
    PH_BEGIN(16) GEMM_R(0, 1, OB, ws + WS_WOB, D, nullptr, AB, nullptr, nullptr, A, SS + 3 * M, nullptr, D, (size_t)128, 0); PH_END(16)
    PH_BEGIN(18) GEMM_B(2, A, ws + WS_WGU1, 2 * FF, D, HB, nullptr, FF, SS + 3 * M); PH_END(18)
    PH_BEGIN(19) GEMM_R(0, 1, HB, ws + WS_WD1, FF, nullptr, A, nullptr, nullptr, A, SS + 4 * M, nullptr, 64, (size_t)M * 128, 0); GEMM_B(0, PBF + (size_t)M * PLE, ws + WS_WEP1, D, PLE, PP, nullptr, D, nullptr); PH_END(19)
    PH_BEGIN(21) GEMM_R(1, 1, A, ws + WS_WEG1, D, nullptr, A, out, PP, nullptr, nullptr, SS + 4 * M, D, (size_t)128, 0); PH_END(21)
}

extern "C" void kernel_launch(void* const* d_in, const int* in_sizes, int n_in, void* d_out, int out_size, void* d_ws, size_t ws_size, hipStream_t stream) {
    static int grid = 0;
    if (grid == 0) {
        if (n_in != 29 || out_size != M * D || ws_size < WS_END) { fprintf(stderr, "kernel_launch: unexpected shapes (n_in %d out %d ws %zu)\n", n_in, out_size, ws_size); grid = -1; return; }
        int dev = 0, cus = 0, per_cu = 0;
        hipGetDevice(&dev); hipDeviceGetAttribute(&cus, hipDeviceAttributeMultiprocessorCount, dev);
        hipFuncSetAttribute((const void*)yoco_fwd, hipFuncAttributeMaxDynamicSharedMemorySize, LDS_BYTES);
        hipOccupancyMaxActiveBlocksPerMultiprocessor(&per_cu, (const void*)yoco_fwd, 512, LDS_BYTES);
        if (per_cu < 1) per_cu = 1;
        grid = cus * per_cu;
        (void)hipGetLastError();
    }
    if (grid < 0) return;
    if (hipMemsetAsync((char*)d_ws + WS_BAR, 0, XCD_BAR_WORDS * 4, stream) != hipSuccess) { fprintf(stderr, "kernel_launch: hipMemsetAsync failed\n"); return; }
    Args a{};
    for (int i = 0; i < 29; ++i) a.in[i] = d_in[i];
    a.out = (float*)d_out; a.ws = (unsigned char*)d_ws; a.ph_lo = 0; a.ph_hi = NPHASE;
    void* kargs[] = {&a};
    hipError_t e = hipLaunchCooperativeKernel((const void*)yoco_fwd, dim3(grid), dim3(512), kargs, LDS_BYTES, stream);
    if (e != hipSuccess) fprintf(stderr, "cooperative launch failed: %s (grid %d)\n", hipGetErrorString(e), grid);
}
```

```cpp
#include <hip/hip_runtime.h>
#include <hip/hip_cooperative_groups.h>
#include <cstdio>
#include <cstdint>
namespace cg = cooperative_groups;

#define LAS __attribute__((address_space(3)))
typedef unsigned short bf16_t;
typedef short bf16x8 __attribute__((ext_vector_type(8)));
typedef float f32x4 __attribute__((ext_vector_type(4)));
typedef float f32x16 __attribute__((ext_vector_type(16)));
typedef unsigned u32x4 __attribute__((ext_vector_type(4)));
typedef unsigned u32x2 __attribute__((ext_vector_type(2)));
typedef short s16x4 __attribute__((ext_vector_type(4)));

constexpr int M = 16384, D = 2048, SEQ = 4096, NB = 4, FF = 5632, NH = 16, PLE = 256;
constexpr int N1P = 1280;
constexpr float EPS = 1e-6f, LOG2E = 1.4426950408889634f;

__device__ __forceinline__ unsigned cvt_pk_bf16(float lo, float hi) { unsigned r; asm volatile("v_cvt_pk_bf16_f32 %0, %1, %2" : "=v"(r) : "v"(lo), "v"(hi)); return r; }
__device__ __forceinline__ float bf2f(unsigned u16) { return __uint_as_float(u16 << 16); }
__device__ __forceinline__ float bflo(unsigned w) { return __uint_as_float(w << 16); }
__device__ __forceinline__ float bfhi(unsigned w) { return __uint_as_float(w & 0xffff0000u); }
__device__ __forceinline__ float wave_sum(float v) {
    v = v + __builtin_bit_cast(float, __builtin_amdgcn_update_dpp(0, __builtin_bit_cast(int, v), 0xB1, 0xF, 0xF, true));
    v = v + __builtin_bit_cast(float, __builtin_amdgcn_update_dpp(0, __builtin_bit_cast(int, v), 0x4E, 0xF, 0xF, true));
    v = v + __builtin_bit_cast(float, __builtin_amdgcn_update_dpp(0, __builtin_bit_cast(int, v), 0x141, 0xF, 0xF, true));
    v = v + __builtin_bit_cast(float, __builtin_amdgcn_update_dpp(0, __builtin_bit_cast(int, v), 0x140, 0xF, 0xF, true));
    v += __shfl_xor(v, 16);
    { const auto rr = __builtin_amdgcn_permlane32_swap(__float_as_uint(v), __float_as_uint(v), false, false); v = __uint_as_float(rr[0]) + __uint_as_float(rr[1]); }
    return v;
}
__device__ __forceinline__ float fsigmoid(float a) { return __builtin_amdgcn_rcpf(1.0f + __builtin_amdgcn_exp2f(-a * LOG2E)); }

namespace pg8 {
constexpr int BM = 256, BK = 64, HALF = 128, HTB = HALF * BK * 2, STAGE_BYTES = 8 * HTB, NXCD = 8, WGM = 8;
__host__ __device__ __forceinline__ int lds_byte(int r, int c) { const int st = (r >> 4) * 2 + (c >> 5), rr = r & 15, cc = c & 31, ob = rr * 64 + cc * 2; return st * 1024 + (ob ^ (((ob >> 9) & 1) << 5)); }
__host__ __device__ __forceinline__ void stage_rc(int b, int& R, int& C) { const int st = b / 1024, sb = b % 1024, swz = sb ^ (((sb >> 9) & 1) << 5); R = (st >> 1) * 16 + swz / 64; C = (st & 1) * 32 + (swz % 64) / 2; }
__host__ __device__ __forceinline__ int perm32(int rho) { const int n = rho >> 4, i = rho & 15; return 8 * (i >> 2) + 4 * n + (i & 3); }

struct Unit { int pm, pn; };
struct Gemm { const bf16_t* A; const bf16_t* Bt; int M, N, K; int lda; size_t kstepA; };

struct StaticOrder {
    int nM, nN, nwg, G, c, wgm, rev;
    __device__ void init(int M_, int N_, int G_, int c_, int rev_ = 0) { nM = M_ / BM; nN = N_ / BM; nwg = nM * nN; G = G_; c = c_; wgm = (nN == 8) ? 4 : WGM; rev = rev_; }
    __device__ bool next(int i, Unit& u) const {
        const long L = (long)i * G + c; if (L >= nwg) return false;
        int wgid = (int)L; { const int q = nwg / NXCD, r = nwg % NXCD, xcd = wgid % NXCD, off = wgid / NXCD; wgid = (xcd < r ? xcd * (q + 1) : r * (q + 1) + (xcd - r) * q) + off; }
        const int nig = wgm * nN, gid = wgid / nig, fm = gid * wgm, gsz = (nM - fm) < wgm ? (nM - fm) : wgm;
        u.pm = fm + ((wgid % nig) % gsz); u.pn = (wgid % nig) / gsz; if (rev) u.pm = nM - 1 - u.pm;
        return true;
    }
};

template <int MODE> struct EpiB {
    static constexpr bool PERM = true;
    bf16_t* O0; bf16_t* O1; int ldc; const float* ss_in;
    __device__ __forceinline__ void operator()(const f32x4 (&acc)[2][2][4][2], const Unit& u, int wr, int wc, int fr, int fq) const {
        const int row0 = u.pm * BM + wr * 64 + fr;
        const int col0 = (MODE == 0 ? u.pn * BM : u.pn * HALF) + wc * 32 + 8 * fq;
        float rsv[2][4];
#pragma unroll
        for (int ai = 0; ai < 2; ++ai)
#pragma unroll
            for (int m = 0; m < 4; ++m) rsv[ai][m] = ss_in ? ss_in[row0 + ai * HALF + m * 16] : 0.f;
#pragma unroll
        for (int ai = 0; ai < 2; ++ai)
#pragma unroll
            for (int m = 0; m < 4; ++m) {
                const size_t roff = (size_t)(row0 + ai * HALF + m * 16) * ldc + col0;
                const float rs = ss_in ? __builtin_amdgcn_rsqf(rsv[ai][m] * (1.0f / D) + EPS) : 1.0f;
                if (MODE == 2) {
                    f32x4 g0 = acc[ai][0][m][0] * rs, g1 = acc[ai][0][m][1] * rs, u0 = acc[ai][1][m][0] * rs, u1 = acc[ai][1][m][1] * rs;
#pragma unroll
                    for (int e = 0; e < 4; ++e) { g0[e] = g0[e] * fsigmoid(g0[e]) * u0[e]; g1[e] = g1[e] * fsigmoid(g1[e]) * u1[e]; }
                    u32x4 w; w.x = cvt_pk_bf16(g0[0], g0[1]); w.y = cvt_pk_bf16(g0[2], g0[3]); w.z = cvt_pk_bf16(g1[0], g1[1]); w.w = cvt_pk_bf16(g1[2], g1[3]);
                    { const int col = col0, row = row0 + ai * HALF + m * 16; *(u32x4*)(O0 + ((size_t)(col >> 6) * M + row) * 64 + (col & 63)) = w; }
                } else {
#pragma unroll
                    for (int bj = 0; bj < 2; ++bj) {
                        const f32x4 v0 = acc[ai][bj][m][0] * rs, v1 = acc[ai][bj][m][1] * rs;
                        u32x4 w; w.x = cvt_pk_bf16(v0[0], v0[1]); w.y = cvt_pk_bf16(v0[2], v0[3]); w.z = cvt_pk_bf16(v1[0], v1[1]); w.w = cvt_pk_bf16(v1[2], v1[3]);
                        if (MODE == 0) *(u32x4*)(O0 + roff + bj * HALF) = w;
                        else *(u32x4*)((bj == 0 ? O0 : O1) + roff) = w;
                    }
                }
            }
    }
};
template <int MODE, int BASE> struct EpiF {
    static constexpr bool PERM = false;
    const float* base; const bf16_t* baseb; float* out; const bf16_t* pp; int ldc;
    bf16_t* xb; float* ss_out;
    const float* ss_in;
    __device__ __forceinline__ void operator()(const f32x4 (&acc)[2][2][4][2], const Unit& u, int wr, int wc, int fr, int fq) const {
        const int row0 = u.pm * BM + wr * 64 + fr, col0 = u.pn * BM + wc * 32 + 4 * fq;
        float rsv[2][4];
        if (MODE == 1) {
#pragma unroll
            for (int ai = 0; ai < 2; ++ai)
#pragma unroll
                for (int m = 0; m < 4; ++m) rsv[ai][m] = ss_in[row0 + ai * HALF + m * 16];
        }
#pragma unroll
        for (int ai = 0; ai < 2; ++ai)
#pragma unroll
            for (int mp = 0; mp < 2; ++mp) {
                f32x4 bv[2][2][2]; u32x2 bw[2][2][2]; u32x2 pv[2][2][2];
#pragma unroll
                for (int mi = 0; mi < 2; ++mi)
#pragma unroll
                    for (int bj = 0; bj < 2; ++bj)
#pragma unroll
                        for (int n = 0; n < 2; ++n) {
                            const size_t c = (size_t)(row0 + ai * HALF + (2 * mp + mi) * 16) * ldc + col0 + bj * HALF + n * 16;
                            if (BASE == 0) bv[mi][bj][n] = *(const f32x4*)(base + c); else bw[mi][bj][n] = *(const u32x2*)(baseb + c);
                            if (MODE == 1) pv[mi][bj][n] = *(const u32x2*)(pp + c);
                        }
#pragma unroll
                for (int mi = 0; mi < 2; ++mi) {
                    const int m = 2 * mp + mi, row = row0 + ai * HALF + m * 16;
                    const size_t roff = (size_t)row * ldc + col0;
                    float rs = 1.0f; if (MODE == 1) rs = __builtin_amdgcn_rsqf(rsv[ai][m] * (1.0f / D) + EPS);
                    float sq = 0.f;
#pragma unroll
                    for (int bj = 0; bj < 2; ++bj)
#pragma unroll
                        for (int n = 0; n < 2; ++n) {
                            const size_t c = roff + bj * HALF + n * 16;
                            f32x4 a = acc[ai][bj][m][n];
                            if (MODE == 1) { const u32x2 p2 = pv[mi][bj][n];
                                a[0] = fsigmoid(a[0] * rs) * bflo(p2.x); a[1] = fsigmoid(a[1] * rs) * bfhi(p2.x); a[2] = fsigmoid(a[2] * rs) * bflo(p2.y); a[3] = fsigmoid(a[3] * rs) * bfhi(p2.y); }
                            f32x4 b;
                            if (BASE == 0) b = bv[mi][bj][n]; else { const u32x2 q = bw[mi][bj][n]; b = (f32x4){bflo(q.x), bfhi(q.x), bflo(q.y), bfhi(q.y)}; }
                            const f32x4 o = b + a;
                            if (out) *(f32x4*)(out + c) = o;
                            if (xb) { u32x2 w; w.x = cvt_pk_bf16(o[0], o[1]); w.y = cvt_pk_bf16(o[2], o[3]); *(u32x2*)(xb + c) = w;
                                const float r0 = bflo(w.x), r1 = bfhi(w.x), r2 = bflo(w.y), r3 = bfhi(w.y); sq += (r0 * r0 + r1 * r1) + (r2 * r2 + r3 * r3); }
                        }
                    if (xb) { sq += __shfl_xor(sq, 16); { const auto rr = __builtin_amdgcn_permlane32_swap(__float_as_uint(sq), __float_as_uint(sq), false, false); sq = __uint_as_float(rr[0]) + __uint_as_float(rr[1]); } if (fq == 0) atomicAdd(ss_out + row, sq); }
                }
            }
    }
};

template <class Epi, class Sched, bool ALIGN_EPI, bool SP2>
__device__ __forceinline__ void gemm_phase(LAS unsigned char* lds, const Gemm g, const Sched& S, const Epi& E, const int tid) {
    const int wid = __builtin_amdgcn_readfirstlane(tid >> 6), lane = tid & 63, wr = wid >> 2, wc = wid & 3, fr = lane & 15, fq = lane >> 4;
    const int K = g.K, nt = K / BK;
    unsigned voffA[2], voffB[2];
#pragma unroll
    for (int i = 0; i < 2; ++i) { int R, C; stage_rc(tid * 16 + i * 8192, R, C); const int Rb = Epi::PERM ? ((R & ~31) + perm32(R & 31)) : R;
        voffA[i] = (unsigned)(R * g.lda + C) * 2u; voffB[i] = (unsigned)(Rb * 64 + C) * 2u; }
    const size_t kstep = (size_t)(BK * 2);
    const size_t hstepA = (size_t)HALF * g.lda * 2, hstepB = (size_t)HALF * 64 * 2;
    const size_t tstepA = 2 * hstepA, tstepB = 2 * hstepB;
    const size_t kstepA = g.kstepA, kstepB = (size_t)g.N * 128;
    const unsigned ldsw = (unsigned)wid * 1024u;
    const int aoff = lds_byte(wr * 64 + fr, fq * 8), boff = lds_byte(wc * 32 + fr, fq * 8);
#define PG8_SA(b, h) (((b) * 2 + (h)) * HTB)
#define PG8_SB(b, h) ((4 + (b) * 2 + (h)) * HTB)
#define PG8_STAGE(bufoff, gbase, voff) do { _Pragma("unroll") for (int _i = 0; _i < 2; ++_i) \
        __builtin_amdgcn_global_load_lds((const unsigned*)((const char*)(gbase) + (voff)[_i]), (LAS unsigned*)(lds + (bufoff) + ldsw + _i * 8192), 16, 0, 0); } while (0)
#define PG8_LDA(dst, b, h) do { _Pragma("unroll") for (int m = 0; m < 4; ++m) _Pragma("unroll") for (int k = 0; k < 2; ++k) dst[m][k] = *(const LAS bf16x8*)(lds + PG8_SA(b, h) + aoff + m * 2048 + k * 1024); } while (0)
#define PG8_LDB(dst, b, h) do { _Pragma("unroll") for (int n = 0; n < 2; ++n) _Pragma("unroll") for (int k = 0; k < 2; ++k) dst[n][k] = *(const LAS bf16x8*)(lds + PG8_SB(b, h) + boff + n * 2048 + k * 1024); } while (0)
#define PG8_MMA(ai, bj, At, Bt) do { __builtin_amdgcn_s_setprio(1); _Pragma("unroll") for (int m = 0; m < 4; ++m) _Pragma("unroll") for (int n = 0; n < 2; ++n) _Pragma("unroll") for (int k = 0; k < 2; ++k) \
        acc[ai][bj][m][n] = __builtin_amdgcn_mfma_f32_16x16x32_bf16(Bt[n][k], At[m][k], acc[ai][bj][m][n], 0, 0, 0); __builtin_amdgcn_s_setprio(0); } while (0)
#define PG8_WAIT_V(n) asm volatile("s_waitcnt vmcnt(" #n ")" ::: "memory")
#define PG8_WAIT_L(n) asm volatile("s_waitcnt lgkmcnt(" #n ")" ::: "memory")
#define PG8_BAR __builtin_amdgcn_s_barrier()
#define PG8_SCHED __builtin_amdgcn_sched_barrier(0)
    Unit cur, nxt; int ui = 0;
    if (!S.next(0, cur)) return;
    f32x4 acc[2][2][4][2];
#pragma unroll
    for (int a = 0; a < 2; ++a)
#pragma unroll
        for (int b = 0; b < 2; ++b)
#pragma unroll
            for (int m = 0; m < 4; ++m)
#pragma unroll
                for (int n = 0; n < 2; ++n) acc[a][b][m][n] = (f32x4){0.f, 0.f, 0.f, 0.f};
    bf16x8 At[4][2], B0[2][2], B1[2][2];
    const char* cA = (const char*)g.A + (size_t)cur.pm * tstepA; const char* cB = (const char*)g.Bt + (size_t)cur.pn * tstepB;
    if constexpr (SP2) {
        PG8_STAGE(PG8_SB(0, 0), cB, voffB); PG8_STAGE(PG8_SB(0, 1), cB + hstepB, voffB); PG8_STAGE(PG8_SA(0, 0), cA, voffA); PG8_STAGE(PG8_SA(0, 1), cA + hstepA, voffA);
        if (wr == 1) PG8_BAR;
        PG8_WAIT_V(2); PG8_BAR;
        PG8_STAGE(PG8_SB(1, 0), cB + kstepB, voffB); PG8_STAGE(PG8_SA(1, 0), cA + kstepA, voffA); PG8_STAGE(PG8_SB(1, 1), cB + hstepB + kstepB, voffB);
        PG8_WAIT_V(6); PG8_BAR;
    } else {
        PG8_STAGE(PG8_SB(0, 0), cB, voffB); PG8_STAGE(PG8_SA(0, 0), cA, voffA); PG8_STAGE(PG8_SB(0, 1), cB + hstepB, voffB); PG8_STAGE(PG8_SA(0, 1), cA + hstepA, voffA);
        if (wr == 1) PG8_BAR;
        PG8_WAIT_V(4); PG8_BAR;
        PG8_STAGE(PG8_SB(1, 0), cB + kstepB, voffB); PG8_STAGE(PG8_SA(1, 0), cA + kstepA, voffA); PG8_STAGE(PG8_SB(1, 1), cB + hstepB + kstepB, voffB);
        PG8_WAIT_V(6); PG8_BAR;
    }
    for (;;) {
        const bool has_next = S.next(ui + 1, nxt);
        const char* nA = has_next ? (const char*)g.A + (size_t)nxt.pm * tstepA : cA; const char* nB = has_next ? (const char*)g.Bt + (size_t)nxt.pn * tstepB : cB;
        for (int t = 0; t < nt; t += 2) {
            const bool last = (t == nt - 2);
            const char* a1 = cA + (size_t)(t + 1) * kstepA;
            const char* a2 = last ? nA : cA + (size_t)(t + 2) * kstepA; const char* b2 = last ? nB : cB + (size_t)(t + 2) * kstepB;
            const char* a3 = a2 + kstepA; const char* b3 = b2 + kstepB;
            if constexpr (SP2) {
            PG8_LDB(B0, 0, 0); PG8_LDB(B1, 0, 1); PG8_SCHED; PG8_LDA(At, 0, 0); PG8_STAGE(PG8_SA(1, 1), a1 + hstepA, voffA);
            PG8_WAIT_V(8); PG8_WAIT_L(0); PG8_BAR; PG8_MMA(0, 0, At, B0); PG8_MMA(0, 1, At, B1); PG8_BAR; PG8_SCHED;
            PG8_LDA(At, 0, 1); PG8_STAGE(PG8_SB(0, 0), b2, voffB); PG8_STAGE(PG8_SB(0, 1), b2 + hstepB, voffB); PG8_STAGE(PG8_SA(0, 0), a2, voffA);
            PG8_WAIT_V(8); PG8_WAIT_L(0); PG8_BAR; PG8_MMA(1, 0, At, B0); PG8_MMA(1, 1, At, B1); PG8_BAR; PG8_SCHED;
            PG8_LDB(B0, 1, 0); PG8_LDB(B1, 1, 1); PG8_SCHED; PG8_LDA(At, 1, 0); PG8_STAGE(PG8_SA(0, 1), a2 + hstepA, voffA);
            PG8_WAIT_V(8); PG8_WAIT_L(0); PG8_BAR; PG8_MMA(0, 0, At, B0); PG8_MMA(0, 1, At, B1); PG8_BAR; PG8_SCHED;
            PG8_LDA(At, 1, 1); PG8_STAGE(PG8_SB(1, 0), b3, voffB); PG8_STAGE(PG8_SB(1, 1), b3 + hstepB, voffB); PG8_STAGE(PG8_SA(1, 0), a3, voffA);
            PG8_WAIT_V(8); PG8_WAIT_L(0); PG8_BAR; PG8_MMA(1, 0, At, B0); PG8_MMA(1, 1, At, B1); PG8_BAR; PG8_SCHED;
            } else {
            PG8_LDB(B0, 0, 0); PG8_SCHED; PG8_LDA(At, 0, 0); PG8_STAGE(PG8_SA(1, 1), a1 + hstepA, voffA);
            PG8_WAIT_L(8); PG8_BAR; PG8_WAIT_L(0); PG8_MMA(0, 0, At, B0); PG8_BAR; PG8_SCHED;
            PG8_LDB(B1, 0, 1); PG8_STAGE(PG8_SB(0, 0), b2, voffB);
            PG8_BAR; PG8_WAIT_L(0); PG8_MMA(0, 1, At, B1); PG8_BAR;
            PG8_LDA(At, 0, 1); PG8_STAGE(PG8_SA(0, 0), a2, voffA);
            PG8_BAR; PG8_WAIT_L(0); PG8_MMA(1, 0, At, B0); PG8_BAR; PG8_SCHED;
            PG8_STAGE(PG8_SB(0, 1), b2 + hstepB, voffB);
            PG8_WAIT_V(6); PG8_BAR; PG8_MMA(1, 1, At, B1); PG8_BAR;
            PG8_LDB(B0, 1, 0); PG8_SCHED; PG8_LDA(At, 1, 0); PG8_STAGE(PG8_SA(0, 1), a2 + hstepA, voffA);
            PG8_WAIT_L(8); PG8_BAR; PG8_WAIT_L(0); PG8_MMA(0, 0, At, B0); PG8_BAR; PG8_SCHED;
            PG8_LDB(B1, 1, 1); PG8_STAGE(PG8_SB(1, 0), b3, voffB);
            PG8_BAR; PG8_WAIT_L(0); PG8_MMA(0, 1, At, B1); PG8_BAR;
            PG8_LDA(At, 1, 1); PG8_STAGE(PG8_SA(1, 0), a3, voffA);
            PG8_BAR; PG8_WAIT_L(0); PG8_MMA(1, 0, At, B0); PG8_BAR; PG8_SCHED;
            PG8_STAGE(PG8_SB(1, 1), b3 + hstepB, voffB);
            PG8_WAIT_V(6); PG8_BAR; PG8_MMA(1, 1, At, B1); PG8_BAR;
            }
        }
        if constexpr (ALIGN_EPI) { if (wr == 0) PG8_BAR; }
        E(acc, cur, wr, wc, fr, fq);
        if (!has_next) break;
#pragma unroll
        for (int a = 0; a < 2; ++a)
#pragma unroll
            for (int b = 0; b < 2; ++b)
#pragma unroll
                for (int m = 0; m < 4; ++m)
#pragma unroll
                    for (int n = 0; n < 2; ++n) acc[a][b][m][n] = (f32x4){0.f, 0.f, 0.f, 0.f};
        cur = nxt; cA = nA; cB = nB; ++ui;
        if constexpr (ALIGN_EPI) { if (wr == 1) PG8_BAR; }
    }
    PG8_WAIT_V(0);
    if constexpr (!ALIGN_EPI) { if (wr == 0) PG8_BAR; }
    PG8_BAR;
#undef PG8_SA
#undef PG8_SB
#undef PG8_STAGE
#undef PG8_LDA
#undef PG8_LDB
#undef PG8_MMA
#undef PG8_WAIT_V
#undef PG8_WAIT_L
#undef PG8_BAR
#undef PG8_SCHED
}
}

struct AttnP { const bf16_t* Q; int ldq, hsq; const bf16_t* K; int ldk, hsk; const bf16_t* V; int ldv, hsv; bf16_t* O; int ldo; const float* bias; const int* pos; const float* gq; const float* cs; const float* sn; };
__device__ __forceinline__ int crow(int r, int hi) { return (r & 3) + 8 * (r >> 2) + 4 * hi; }

template <int DQK, bool BAND>
__device__ __forceinline__ void attn_phase(LAS unsigned char* lds, const AttnP P, const int tid) {
    constexpr int SK = DQK * 2 + 16, SV = 320;
    constexpr int KBYTES = 64 * SK, VBYTES = 64 * SV, BUF = KBYTES + VBYTES;
    constexpr int OFF_KPOS = 2 * BUF, OFF_BIAS = OFF_KPOS + 512, OFF_KMAX = OFF_BIAS + 2112;
    constexpr int CPR = DQK / 8, NKC = 64 * CPR / 512, NDS = DQK / 16;
    const int lane = tid & 63, r32 = lane & 31, hi = lane >> 5;
    const int wid = __builtin_amdgcn_readfirstlane(tid >> 6);
    LAS int* kposL = (LAS int*)(lds + OFF_KPOS);
    LAS float* biasL = (LAS float*)(lds + OFF_BIAS);
    LAS int* kmaxL = (LAS int*)(lds + OFF_KMAX);
    constexpr int NUNITS = NB * NH * (SEQ / 256);
    for (int ui = blockIdx.x; ui < NUNITS; ui += gridDim.x) {
        const int jr = ui >> 8, vv = ui & 255, bh = vv >> 2, s4 = vv & 3;
        const int qb = (jr == 0) ? s4 : (jr == 1) ? 7 - s4 : (jr == 2) ? 8 + s4 : 15 - s4;
        const int b = bh / NH, h = bh % NH;
        const size_t rowbase = (size_t)b * SEQ; const int q0 = qb * 256;
        const int cw = 4 * qb + (wid >> 1);
        const int t_lo = BAND ? (4 * qb - 8 > 0 ? 4 * qb - 8 : 0) : 0, t_hi = 4 * qb + 3;
        const int w_lo = BAND ? (cw - 8 > 0 ? cw - 8 : 0) : 0, w_hi = cw;
        bf16x8 qf[NDS];
        { const bf16_t* qp = P.Q + (rowbase + q0 + wid * 32 + r32) * P.ldq + h * P.hsq + hi * 8;
#pragma unroll
          for (int ds = 0; ds < NDS; ++ds) qf[ds] = *(const bf16x8*)(qp + ds * 16); }
        {
            float ssq = 0.f;
#pragma unroll
            for (int ds = 0; ds < NDS; ++ds)
#pragma unroll
                for (int e = 0; e < 8; ++e) { const float v = bf2f((unsigned)(unsigned short)qf[ds][e]); ssq += v * v; }
            ssq += __shfl_xor(ssq, 32);
            const float rq = __builtin_amdgcn_rsqf(ssq * (1.0f / DQK) + EPS) * ((BAND ? 0.08838834764831845f : 0.07216878364870322f) * LOG2E);
            const size_t tok = rowbase + q0 + wid * 32 + r32;
#pragma unroll
            for (int ds = 0; ds < 8; ++ds) {
                const f32x4 g0 = *(const f32x4*)(P.gq + ds * 16 + hi * 8), g1 = *(const f32x4*)(P.gq + ds * 16 + hi * 8 + 4);
                u32x4 w;
                w.x = cvt_pk_bf16(bf2f((unsigned)(unsigned short)qf[ds][0]) * rq * g0[0], bf2f((unsigned)(unsigned short)qf[ds][1]) * rq * g0[1]);
                w.y = cvt_pk_bf16(bf2f((unsigned)(unsigned short)qf[ds][2]) * rq * g0[2], bf2f((unsigned)(unsigned short)qf[ds][3]) * rq * g0[3]);
                w.z = cvt_pk_bf16(bf2f((unsigned)(unsigned short)qf[ds][4]) * rq * g1[0], bf2f((unsigned)(unsigned short)qf[ds][5]) * rq * g1[1]);
                w.w = cvt_pk_bf16(bf2f((unsigned)(unsigned short)qf[ds][6]) * rq * g1[2], bf2f((unsigned)(unsigned short)qf[ds][7]) * rq * g1[3]);
                qf[ds] = __builtin_bit_cast(bf16x8, w);
            }
            if (!BAND)
#pragma unroll
            for (int j = 0; j < 2; ++j) {
                const int i0 = 16 * j + 8 * hi;
                float o1[8], o2[8];
                const f32x4 cA = *(const f32x4*)(P.cs + tok * 32 + i0), cB = *(const f32x4*)(P.cs + tok * 32 + i0 + 4), sA = *(const f32x4*)(P.sn + tok * 32 + i0), sB = *(const f32x4*)(P.sn + tok * 32 + i0 + 4);
                const f32x4 g1A = *(const f32x4*)(P.gq + 128 + i0), g1B = *(const f32x4*)(P.gq + 128 + i0 + 4), g2A = *(const f32x4*)(P.gq + 160 + i0), g2B = *(const f32x4*)(P.gq + 160 + i0 + 4);
#pragma unroll
                for (int e = 0; e < 8; ++e) {
                    const float c = e < 4 ? cA[e & 3] : cB[e & 3], sn_ = e < 4 ? sA[e & 3] : sB[e & 3];
                    const float x1 = bf2f((unsigned)(unsigned short)qf[8 + j][e]) * rq * (e < 4 ? g1A[e & 3] : g1B[e & 3]), x2 = bf2f((unsigned)(unsigned short)qf[10 + j][e]) * rq * (e < 4 ? g2A[e & 3] : g2B[e & 3]);
                    o1[e] = x1 * c - x2 * sn_; o2[e] = x2 * c + x1 * sn_;
                }
                u32x4 w1, w2;
                w1.x = cvt_pk_bf16(o1[0], o1[1]); w1.y = cvt_pk_bf16(o1[2], o1[3]); w1.z = cvt_pk_bf16(o1[4], o1[5]); w1.w = cvt_pk_bf16(o1[6], o1[7]);
                w2.x = cvt_pk_bf16(o2[0], o2[1]); w2.y = cvt_pk_bf16(o2[2], o2[3]); w2.z = cvt_pk_bf16(o2[4], o2[5]); w2.w = cvt_pk_bf16(o2[6], o2[7]);
                qf[8 + j] = __builtin_bit_cast(bf16x8, w1); qf[10 + j] = __builtin_bit_cast(bf16x8, w2);
            }
        }
        int qpos = 0;
        if (BAND) { for (int i = tid; i < 513; i += 512) biasL[i] = P.bias[h * 513 + i] * LOG2E; qpos = P.pos[rowbase + q0 + wid * 32 + r32]; }
        int qmin = qpos;
        if (BAND) {
#pragma unroll
            for (int o = 1; o < 64; o <<= 1) { const int t_ = __shfl_xor(qmin, o); qmin = t_ < qmin ? t_ : qmin; }
        }
        f32x16 o[4];
#pragma unroll
        for (int d = 0; d < 4; ++d)
#pragma unroll
            for (int r = 0; r < 16; ++r) o[d][r] = 0.f;
        float mrun = -1e30f, lrun = 0.f;
        u32x4 kreg[NKC], vreg[2]; int kpreg = 0;
        const bf16_t* Kh = P.K + rowbase * P.ldk + h * P.hsk; const bf16_t* Vh = P.V + rowbase * P.ldv + h * P.hsv;
        unsigned kgo[NKC], klo[NKC], vgo[2], vlo[2];
#pragma unroll
        for (int i = 0; i < NKC; ++i) { const int c = tid + i * 512, row = c / CPR, cc = c % CPR; kgo[i] = (unsigned)(row * P.ldk + cc * 8); klo[i] = (unsigned)(row * SK + cc * 16); }
#pragma unroll
        for (int i = 0; i < 2; ++i) { const int c = tid + i * 512, row = c >> 4, cc = c & 15; vgo[i] = (unsigned)(row * P.ldv + cc * 8); vlo[i] = (unsigned)(KBYTES + row * SV + cc * 16); }
#define ATT_BAR() do { asm volatile("s_waitcnt lgkmcnt(0)" ::: "memory"); __builtin_amdgcn_s_barrier(); asm volatile("" ::: "memory"); } while (0)
#define ATT_LOADK(t) do { const bf16_t* kt_ = Kh + (size_t)(t) * 64 * P.ldk; _Pragma("unroll") for (int i = 0; i < NKC; ++i) kreg[i] = *(const u32x4*)(kt_ + kgo[i]); } while (0)
#define ATT_LOADV(t) do { const bf16_t* vt_ = Vh + (size_t)(t) * 64 * P.ldv; _Pragma("unroll") for (int i = 0; i < 2; ++i) vreg[i] = *(const u32x4*)(vt_ + vgo[i]); \
        if (BAND) { if (tid < 64) kpreg = P.pos[rowbase + (t) * 64 + tid]; } } while (0)
#define ATT_STOREK(bufi) do { LAS unsigned char* kb_ = lds + (bufi) * BUF; _Pragma("unroll") for (int i = 0; i < NKC; ++i) *(LAS u32x4*)(kb_ + klo[i]) = kreg[i]; } while (0)
#define ATT_STOREV(bufi) do { LAS unsigned char* kb_ = lds + (bufi) * BUF; _Pragma("unroll") for (int i = 0; i < 2; ++i) *(LAS u32x4*)(kb_ + vlo[i]) = vreg[i]; \
        if (BAND) { if (tid < 64) { kposL[(bufi) * 64 + tid] = kpreg; int mx_ = kpreg; _Pragma("unroll") for (int o = 1; o < 64; o <<= 1) { const int t_ = __shfl_xor(mx_, o); mx_ = t_ > mx_ ? t_ : mx_; } if (tid == 0) kmaxL[(bufi)] = mx_; } } } while (0)
        ATT_LOADK(t_lo); ATT_LOADV(t_lo); ATT_STOREK(0); ATT_STOREV(0); __syncthreads();
        const int grp = wid >> 2;
        { const int t1 = t_lo < t_hi ? t_lo + 1 : t_hi; ATT_LOADK(t1); ATT_LOADV(t1); }
        if (grp == 1) ATT_BAR();
        for (int t = t_lo; t <= t_hi; ++t) {
            const int cur = (t - t_lo) & 1;
            const int tn = t + 2 < t_hi ? t + 2 : t_hi;
            const bool part = (t >= w_lo && t <= w_hi);
            const LAS unsigned char* Kb = lds + cur * BUF; const LAS unsigned char* Vb = Kb + KBYTES;
            f32x16 p0, p1;
            if (part) {
#pragma unroll
                for (int r = 0; r < 16; ++r) { p0[r] = 0.f; p1[r] = 0.f; }
#pragma unroll
                for (int ds = 0; ds < NDS; ++ds) {
                    const bf16x8 k0 = *(const LAS bf16x8*)(Kb + r32 * SK + ds * 32 + hi * 16);
                    const bf16x8 k1 = *(const LAS bf16x8*)(Kb + (32 + r32) * SK + ds * 32 + hi * 16);
                    p0 = __builtin_amdgcn_mfma_f32_32x32x16_bf16(k0, qf[ds], p0, 0, 0, 0);
                    p1 = __builtin_amdgcn_mfma_f32_32x32x16_bf16(k1, qf[ds], p1, 0, 0, 0);
                    if ((ds & 1) == 1) __builtin_amdgcn_sched_barrier(0);
                }
            }
            ATT_STOREK(cur ^ 1); ATT_LOADK(tn);
            ATT_BAR();
            if (part) {
                if (BAND && qmin - kmaxL[cur] >= 256) {
                    const float bc = biasL[512];
#pragma unroll
                    for (int r = 0; r < 16; ++r) { p0[r] += bc; p1[r] += bc; }
                } else if (BAND) {
#pragma unroll
                    for (int r = 0; r < 16; ++r) { const int key = crow(r, hi);
                        int r0 = qpos - kposL[cur * 64 + key], r1 = qpos - kposL[cur * 64 + 32 + key];
                        r0 = (r0 < -256 ? -256 : (r0 > 256 ? 256 : r0)) + 256; r1 = (r1 < -256 ? -256 : (r1 > 256 ? 256 : r1)) + 256;
                        p0[r] += biasL[r0]; p1[r] += biasL[r1]; }
                }
                float mx = p0[0];
#pragma unroll
                for (int r = 1; r < 16; ++r) mx = fmaxf(mx, p0[r]);
#pragma unroll
                for (int r = 0; r < 16; ++r) mx = fmaxf(mx, p1[r]);
                { const auto rr = __builtin_amdgcn_permlane32_swap(__float_as_uint(mx), __float_as_uint(mx), false, false); mx = fmaxf(__uint_as_float(rr[0]), __uint_as_float(rr[1])); }
                if (__any(mx > mrun + 6.0f)) {
                    const float mnew = fmaxf(mrun, mx), alpha = __builtin_amdgcn_exp2f(mrun - mnew); mrun = mnew;
                    lrun *= alpha;
#pragma unroll
                    for (int d = 0; d < 4; ++d)
#pragma unroll
                        for (int r = 0; r < 16; ++r) o[d][r] *= alpha;
                }
                float ls = 0.f;
#pragma unroll
                for (int r = 0; r < 16; ++r) { p0[r] = __builtin_amdgcn_exp2f(p0[r] - mrun); p1[r] = __builtin_amdgcn_exp2f(p1[r] - mrun); ls += p0[r] + p1[r]; }
                lrun += ls;
                const LAS unsigned char* vbase = Vb + (4 * hi + ((lane & 15) >> 2)) * SV + (16 * ((lane >> 4) & 1) + 4 * (lane & 3)) * 2;
#pragma unroll
                for (int kb = 0; kb < 2; ++kb)
#pragma unroll
                    for (int s = 0; s < 2; ++s) {
                        u32x4 pw;
                        if (kb == 0) { pw.x = cvt_pk_bf16(p0[8 * s + 0], p0[8 * s + 1]); pw.y = cvt_pk_bf16(p0[8 * s + 2], p0[8 * s + 3]); pw.z = cvt_pk_bf16(p0[8 * s + 4], p0[8 * s + 5]); pw.w = cvt_pk_bf16(p0[8 * s + 6], p0[8 * s + 7]); }
                        else         { pw.x = cvt_pk_bf16(p1[8 * s + 0], p1[8 * s + 1]); pw.y = cvt_pk_bf16(p1[8 * s + 2], p1[8 * s + 3]); pw.z = cvt_pk_bf16(p1[8 * s + 4], p1[8 * s + 5]); pw.w = cvt_pk_bf16(p1[8 * s + 6], p1[8 * s + 7]); }
                        const bf16x8 pb = __builtin_bit_cast(bf16x8, pw);
#pragma unroll
                        for (int d = 0; d < 4; ++d) {
                            const LAS unsigned char* ap = vbase + (32 * kb + 16 * s) * SV + d * 64;
                            const s16x4 lo = __builtin_bit_cast(s16x4, __builtin_amdgcn_ds_read_tr16_b64_v4i16((LAS s16x4*)ap));
                            const s16x4 h4 = __builtin_bit_cast(s16x4, __builtin_amdgcn_ds_read_tr16_b64_v4i16((LAS s16x4*)(ap + 8 * SV)));
                            const bf16x8 va = (bf16x8){lo[0], lo[1], lo[2], lo[3], h4[0], h4[1], h4[2], h4[3]};
                            o[d] = __builtin_amdgcn_mfma_f32_32x32x16_bf16(va, pb, o[d], 0, 0, 0);
                        }
                        __builtin_amdgcn_sched_barrier(0);
                    }
            }
            ATT_STOREV(cur ^ 1); ATT_LOADV(tn);
            ATT_BAR();
        }
        if (grp == 0) ATT_BAR();
#undef ATT_BAR
#undef ATT_LOADK
#undef ATT_LOADV
#undef ATT_STOREK
#undef ATT_STOREV
        const float ltot = lrun + __shfl_xor(lrun, 32), inv = 1.0f / ltot;
        bf16_t* op = P.O + (rowbase + q0 + wid * 32 + r32) * P.ldo + h * 128 + 4 * hi;
#pragma unroll
        for (int d = 0; d < 4; ++d)
#pragma unroll
            for (int g4 = 0; g4 < 4; ++g4) {
                u32x2 w; w.x = cvt_pk_bf16(o[d][4 * g4 + 0] * inv, o[d][4 * g4 + 1] * inv); w.y = cvt_pk_bf16(o[d][4 * g4 + 2] * inv, o[d][4 * g4 + 3] * inv);
                *(u32x2*)(op + 32 * d + 8 * g4) = w;
            }
    }
}

constexpr size_t MiB = 1u << 20;
constexpr size_t WS_W1 = 1 * MiB, WS_WUQ = 6 * MiB, WS_WUKV = 9 * MiB, WS_WOA = 13 * MiB, WS_WGU0 = 21 * MiB, WS_WGU1 = 65 * MiB, WS_WD0 = 109 * MiB, WS_WD1 = 131 * MiB,
                 WS_WEG0 = 153 * MiB, WS_WEG1 = 161 * MiB, WS_WEP0 = 169 * MiB, WS_WEP1 = 170 * MiB, WS_WSKVQ = 171 * MiB, WS_WOB = 195 * MiB;
constexpr size_t WS_PBF = 203 * MiB;
constexpr size_t WS_A = 219 * MiB;
constexpr size_t WS_PP = 283 * MiB;
constexpr size_t WS_RAW1 = 347 * MiB;
constexpr size_t WS_KA = 387 * MiB;
constexpr size_t WS_CQN = 387 * MiB, WS_CKVN = 403 * MiB;
constexpr size_t WS_H = 347 * MiB;
constexpr size_t WS_RAW3 = 219 * MiB;
constexpr size_t WS_AB = 475 * MiB;
constexpr size_t WS_OB = 411 * MiB;
constexpr size_t WS_SS = 65536;
constexpr size_t WS_ROPE = 500 * MiB;
constexpr size_t WS_END = 539 * MiB;
constexpr int LDS_BYTES = 135168;
constexpr int NPHASE = 22;
constexpr int REP_P0 = 1, REP_P5 = 1, REP_P7 = 1, REP_P15 = 1, EXTRA_SYNCS = 0;
#define PROBE_DUP8 0
#define PROBE_DUP13 0
#define PROBE_DUP6 0
#define PROBE_DUP1 0
#define PROBE_DUP3 0

#define XB_TMO      128
#define XB_XCNT(j)  (256  + 64 * (j))
#define XB_XSUB(j)  (1280 + 64 * (j))
#define XB_XGEN(j)  (2304 + 64 * (j))
#define XB_TOP      3328
#define XB_TOPGEN   3392
#define XCD_BAR_WORDS 3456
#define XB_SPIN_CAP (1u << 18)

__device__ __forceinline__ unsigned xb_ld(unsigned* p)              { return __hip_atomic_load(p, __ATOMIC_RELAXED, __HIP_MEMORY_SCOPE_AGENT); }
__device__ __forceinline__ unsigned xb_add(unsigned* p, unsigned v) { return __hip_atomic_fetch_add(p, v, __ATOMIC_RELAXED, __HIP_MEMORY_SCOPE_AGENT); }
__device__ __forceinline__ unsigned xb_xcc_id() { return (unsigned)__builtin_amdgcn_s_getreg((3 << 11) | 20) & 0xFu; }
#define XB_SPIN(cond, bar) do { unsigned _sp = 0; while (cond) { __builtin_amdgcn_s_sleep(1); \
    if ((++_sp & 255u) == 0u) { if (xb_ld(&(bar)[XB_TMO])) break; if (_sp > XB_SPIN_CAP) { atomicAdd(&(bar)[XB_TMO], 1u); break; } } } } while (0)

struct XcdBarrier {
    unsigned* bar; unsigned x;
    volatile LAS unsigned* st;
};

__device__ __forceinline__ XcdBarrier xcd_barrier_post(unsigned* bar, volatile LAS unsigned* st) {
    XcdBarrier b; b.bar = bar; b.x = xb_xcc_id(); b.st = st;
    if (threadIdx.x == 0) (void)xb_add(&bar[XB_XCNT(b.x)], 1u);
    return b;
}
__device__ __forceinline__ void xcd_barrier_complete(unsigned* bar, unsigned x, unsigned& nloc, unsigned& nx) {
    const unsigned G = gridDim.x * gridDim.y * gridDim.z;
    unsigned sum, cnt, mine, sp = 0u;
    for (;;) {
        sum = 0u; cnt = 0u; mine = 0u;
#pragma unroll
        for (unsigned j = 0; j < 16; ++j) { const unsigned c = xb_ld(&bar[XB_XCNT(j)]); sum += c; cnt += (c > 0u) ? 1u : 0u; mine = (j == x) ? c : mine; }
        if (sum == G) break;
        __builtin_amdgcn_s_sleep(1);
        if ((++sp & 255u) == 0u) { if (xb_ld(&bar[XB_TMO])) break; if (sp > XB_SPIN_CAP) { atomicAdd(&bar[XB_TMO], 1u); break; } }
    }
    nloc = mine > 0u ? mine : 1u; nx = cnt > 0u ? cnt : 1u;
}

__device__ __forceinline__ void xcd_barrier(const XcdBarrier& b) {
    asm volatile("s_waitcnt vmcnt(0)" ::: "memory");
    __syncthreads();
    if (threadIdx.x == 0) {
        unsigned* bar = b.bar;
        __builtin_amdgcn_s_waitcnt(0);
        unsigned nloc = b.st[0], nx = b.st[1];
        if (nloc == 0u) { xcd_barrier_complete(bar, b.x, nloc, nx); b.st[0] = nloc; b.st[1] = nx; }
        const unsigned old = xb_add(&bar[XB_XSUB(b.x)], 1u);
        const unsigned gen = old / nloc;
        if (old + 1u == (gen + 1u) * nloc) {
            __builtin_amdgcn_fence(__ATOMIC_RELEASE, "agent");
            asm volatile("s_waitcnt vmcnt(0)" ::: "memory");
            const unsigned og = xb_add(&bar[XB_TOP], 1u);
            const unsigned tg = og / nx;
            if (og + 1u == (tg + 1u) * nx) xb_add(&bar[XB_TOPGEN], 1u);
            else XB_SPIN(xb_ld(&bar[XB_TOPGEN]) == tg, bar);
            __builtin_amdgcn_fence(__ATOMIC_ACQUIRE, "agent");
            xb_add(&bar[XB_XGEN(b.x)], 1u);
            asm volatile("s_waitcnt vmcnt(0)" ::: "memory");
        } else {
            XB_SPIN(xb_ld(&bar[XB_XGEN(b.x)]) == gen, bar);
            __builtin_amdgcn_fence(__ATOMIC_ACQUIRE, "agent");
            asm volatile("s_waitcnt vmcnt(0)" ::: "memory");
        }
    }
    __syncthreads();
}


constexpr size_t WS_BAR = 16384;
constexpr int LDS_MISC = 131072 + 64;

struct Args { const void* in[29]; float* out; unsigned char* ws; int ph_lo, ph_hi; };

__device__ __forceinline__ void tr_item(const float* W, int N, const float* g, bf16_t* WT, int ldk, int drow, int k0, int n0, LAS float* scr, int lane) {
    float v[32];
    const float* wp = W + (size_t)(k0 + (lane >> 5)) * N + n0 + (lane & 31);
#pragma unroll
    for (int i = 0; i < 32; ++i) v[i] = __builtin_nontemporal_load(wp + (size_t)(2 * i) * N);
    if (g) {
#pragma unroll
        for (int i = 0; i < 32; ++i) v[i] *= g[k0 + 2 * i + (lane >> 5)];
    }
#pragma unroll
    for (int i = 0; i < 32; ++i) scr[(2 * i + (lane >> 5)) * 33 + (lane & 31)] = v[i];
    asm volatile("s_waitcnt lgkmcnt(0)" ::: "memory");
    const int c = lane & 7;
#pragma unroll
    for (int j = 0; j < 4; ++j) { const int n = (lane >> 3) + 8 * j; const LAS float* s = scr + (8 * c) * 33 + n;
        u32x4 o; o.x = cvt_pk_bf16(s[0 * 33], s[1 * 33]); o.y = cvt_pk_bf16(s[2 * 33], s[3 * 33]); o.z = cvt_pk_bf16(s[4 * 33], s[5 * 33]); o.w = cvt_pk_bf16(s[6 * 33], s[7 * 33]);
        *(u32x4*)(WT + ((size_t)(k0 >> 6) * ldk + drow + n) * 64 + 8 * c) = o; }
    asm volatile("s_waitcnt lgkmcnt(0)" ::: "memory");
}
template <int KIND>
__device__ __forceinline__ void conv_matrix(const float* W, int K, int N, const float* g, bf16_t* WT, int NR, int row_off, int gw, int NGW, LAS float* scr, int lane) {
    const int nblk = N / 32, nitems = (K / 64) * nblk;
    for (int it = gw; it < nitems; it += NGW) { const int kb = it / nblk, nb = it % nblk, n0 = 32 * nb;
        const int drow = KIND == 0 ? row_off + n0 : ((n0 >> 7) * 256 + row_off * 128 + (n0 & 127));
        tr_item(W, N, g, WT, NR, drow, 64 * kb, n0, scr, lane); }
}
__device__ __forceinline__ void rms_row(const float* xrow, bf16_t* orow, int lane) {
    const f32x4* xr = (const f32x4*)xrow + lane;
    f32x4 v[8]; float s = 0.f;
#pragma unroll
    for (int j = 0; j < 8; ++j) { v[j] = xr[64 * j]; s += (v[j].x * v[j].x + v[j].y * v[j].y) + (v[j].z * v[j].z + v[j].w * v[j].w); }
    const float rstd = __builtin_amdgcn_rsqf(wave_sum(s) * (1.0f / D) + EPS);
    u32x2* o8 = (u32x2*)orow + lane;
#pragma unroll
    for (int j = 0; j < 8; ++j) { u32x2 w; w.x = cvt_pk_bf16(v[j].x * rstd, v[j].y * rstd); w.y = cvt_pk_bf16(v[j].z * rstd, v[j].w * rstd); o8[64 * j] = w; }
}

#define PH_BEGIN(k) if (ph_lo <= (k) && (k) < ph_hi) { \
        int tid = wave_s * 64 + (int)__builtin_amdgcn_mbcnt_hi(~0u, __builtin_amdgcn_mbcnt_lo(~0u, 0u)); asm volatile("" : "+v"(tid)); \
        const __attribute__((address_space(4))) Args* ap = (const __attribute__((address_space(4))) Args*)__builtin_amdgcn_kernarg_segment_ptr(); asm volatile("" : "+s"(ap)); \
        const int lane = tid & 63, wave = __builtin_amdgcn_readfirstlane(tid >> 6), gw = blockIdx.x * 8 + wave, NGW = G * 8; \
        unsigned char* ws = ap->ws; float* out = ap->out; \
        const float* x = (const float*)ap->in[0]; const float* pin = (const float*)ap->in[1]; const int* positions = (const int*)ap->in[2]; \
        bf16_t* A = (bf16_t*)(ws + WS_A); bf16_t* PP = (bf16_t*)(ws + WS_PP); bf16_t* PBF = (bf16_t*)(ws + WS_PBF); \
        bf16_t* RAW1 = (bf16_t*)(ws + WS_RAW1); bf16_t* KA = (bf16_t*)(ws + WS_KA); bf16_t* CQN = (bf16_t*)(ws + WS_CQN); bf16_t* CKVN = (bf16_t*)(ws + WS_CKVN); \
        bf16_t* HB = (bf16_t*)(ws + WS_H); bf16_t* RAW3 = (bf16_t*)(ws + WS_RAW3); \
        bf16_t* QA = (bf16_t*)out; bf16_t* VA = A; bf16_t* KN = PP; bf16_t* OA = PP; bf16_t* OB = (bf16_t*)(ws + WS_OB); bf16_t* AB = (bf16_t*)(ws + WS_AB); float* SS = (float*)(ws + WS_SS); \
        (void)lane; (void)wave; (void)gw; (void)NGW; (void)x; (void)pin; (void)positions; (void)PBF; (void)RAW1; (void)KA; (void)CQN; (void)CKVN; (void)HB; (void)RAW3; (void)QA; (void)VA; (void)KN; (void)OA; (void)OB; (void)AB; (void)SS;
#define PH_END(k) if ((k) + 1 < ph_hi) { if (ph_hi > NPHASE) grid.sync(); else xcd_barrier(xbar); } }
#define GEMM_B(MODE, Aptr, Bptr, Nv, Kv, O0v, O1v, ldcv, ssin) do { pg8::Gemm g{Aptr, (const bf16_t*)(Bptr), M, Nv, Kv, Kv, (size_t)128}; pg8::StaticOrder So; So.init(M, Nv, G, (int)blockIdx.x); \
        pg8::EpiB<MODE> E{O0v, O1v, ldcv, ssin}; pg8::gemm_phase<pg8::EpiB<MODE>, pg8::StaticOrder, true, true>(lds, g, So, E, tid); } while (0)
#define GEMM_BX(MODE, ALIGN, Aptr, Bptr, Nv, Kv, O0v, O1v, ldcv, ssin) do { pg8::Gemm g{Aptr, (const bf16_t*)(Bptr), M, Nv, Kv, Kv, (size_t)128}; pg8::StaticOrder So; So.init(M, Nv, G, (int)blockIdx.x); \
        pg8::EpiB<MODE> E{O0v, O1v, ldcv, ssin}; pg8::gemm_phase<pg8::EpiB<MODE>, pg8::StaticOrder, ALIGN, true>(lds, g, So, E, tid); } while (0)
#define GEMM_R(MODE, BASE, Aptr, Bptr, Kv, basefv, basebv, outv, ppv, xbv, ssoutv, ssinv, ldav, kstepv, revv) do { pg8::Gemm g{Aptr, (const bf16_t*)(Bptr), M, D, Kv, ldav, kstepv}; pg8::StaticOrder So; So.init(M, D, G, (int)blockIdx.x, revv); \
        pg8::EpiF<MODE, BASE> E{basefv, basebv, outv, ppv, D, xbv, ssoutv, ssinv}; pg8::gemm_phase<pg8::EpiF<MODE, BASE>, pg8::StaticOrder, true, true>(lds, g, So, E, tid); } while (0)
#define NORM_PASS() do { for (int m = gw; m < M; m += NGW) rms_row(out + (size_t)m * D, A + (size_t)m * D, lane); } while (0)

__global__ void __launch_bounds__(512, 2) yoco_fwd(Args args) {
    extern __shared__ __attribute__((aligned(16))) unsigned char lds_raw[];
    LAS unsigned char* lds = (LAS unsigned char*)lds_raw;
    cg::grid_group grid = cg::this_grid();
    const int G = gridDim.x, ph_lo = args.ph_lo, ph_hi = args.ph_hi;
    const int wave_s = __builtin_amdgcn_readfirstlane(threadIdx.x >> 6);
    if (threadIdx.x < 2) ((volatile LAS unsigned*)(lds + LDS_MISC))[threadIdx.x] = 0u;
    __syncthreads();
    XcdBarrier xbar = xcd_barrier_post((unsigned*)(args.ws + WS_BAR), (volatile LAS unsigned*)(lds + LDS_MISC));

    PH_BEGIN(0)
        for (int i = blockIdx.x * 512 + tid; i < 5 * M; i += G * 512) SS[i] = 0.f;
        for (int rep = 0; rep < REP_P0; ++rep) { if (rep) grid.sync();
            LAS float* scr = (LAS float*)(lds + wave * 16384);
            const float* a_norm = (const float*)ap->in[3];
            conv_matrix<0>((const float*)ap->in[4], D, 512, a_norm, (bf16_t*)(ws + WS_W1), N1P, 0, gw, NGW, scr, lane);
            conv_matrix<0>((const float*)ap->in[7], D, 576, a_norm, (bf16_t*)(ws + WS_W1), N1P, 512, gw, NGW, scr, lane);
            { const int per = 192 * 64 * 2 / 16, nz = (D / 64) * per; for (int i = blockIdx.x * 512 + tid; i < nz; i += G * 512) { const int kt = i / per, j = i % per; ((u32x4*)((bf16_t*)(ws + WS_W1) + ((size_t)kt * N1P + 1088) * 64))[j] = (u32x4){0u, 0u, 0u, 0u}; } }
            conv_matrix<0>((const float*)ap->in[6], 512, 3072, (const float*)ap->in[5], (bf16_t*)(ws + WS_WUQ), 3072, 0, gw, NGW, scr, lane);
            conv_matrix<0>((const float*)ap->in[9], 512, 4096, (const float*)ap->in[8], (bf16_t*)(ws + WS_WUKV), 4096, 0, gw, NGW, scr, lane);
            conv_matrix<0>((const float*)ap->in[12], D, D, nullptr, (bf16_t*)(ws + WS_WOA), D, 0, gw, NGW, scr, lane);
            conv_matrix<0>((const float*)ap->in[14], D, D, (const float*)ap->in[13], (bf16_t*)(ws + WS_WSKVQ), 6144, 0, gw, NGW, scr, lane);
            conv_matrix<0>((const float*)ap->in[15], D, D, (const float*)ap->in[13], (bf16_t*)(ws + WS_WSKVQ), 6144, 2048, gw, NGW, scr, lane);
            conv_matrix<0>((const float*)ap->in[18], D, D, (const float*)ap->in[17], (bf16_t*)(ws + WS_WSKVQ), 6144, 4096, gw, NGW, scr, lane);
            conv_matrix<0>((const float*)ap->in[21], D, D, nullptr, (bf16_t*)(ws + WS_WOB), D, 0, gw, NGW, scr, lane);
            for (int l = 0; l < 2; ++l) {
                const float* fn = (const float*)ap->in[22] + l * D; const float* en = (const float*)ap->in[26] + l * D;
                bf16_t* wgu = (bf16_t*)(ws + (l ? WS_WGU1 : WS_WGU0));
                if (l == 0 || G <= 64) conv_matrix<1>((const float*)ap->in[23] + (size_t)l * D * FF, D, FF, fn, wgu, 2 * FF, 0, gw, NGW, scr, lane);
                if (l == 0 || G <= 64) conv_matrix<1>((const float*)ap->in[24] + (size_t)l * D * FF, D, FF, fn, wgu, 2 * FF, 1, gw, NGW, scr, lane);
                if (l == 0 || (G & 3) != 0) conv_matrix<0>((const float*)ap->in[25] + (size_t)l * FF * D, FF, D, nullptr, (bf16_t*)(ws + (l ? WS_WD1 : WS_WD0)), D, 0, gw, NGW, scr, lane);
                conv_matrix<0>((const float*)ap->in[27] + (size_t)l * D * D, D, D, en, (bf16_t*)(ws + (l ? WS_WEG1 : WS_WEG0)), D, 0, gw, NGW, scr, lane);
                conv_matrix<0>((const float*)ap->in[28] + (size_t)l * PLE * D, PLE, D, nullptr, (bf16_t*)(ws + (l ? WS_WEP1 : WS_WEP0)), D, 0, gw, NGW, scr, lane);
            }
            if (G <= 64) { const int n4 = 2 * M * PLE / 4; const f32x4* p4 = (const f32x4*)pin; u32x2* o2 = (u32x2*)PBF;
              for (int i = blockIdx.x * 512 + tid; i < n4; i += G * 512) { const f32x4 v = p4[i]; u32x2 w; w.x = cvt_pk_bf16(v.x, v.y); w.y = cvt_pk_bf16(v.z, v.w); o2[i] = w; } }
            for (int m = gw; m < M; m += NGW) rms_row(x + (size_t)m * D, A + (size_t)m * D, lane);
        }
    PH_END(0)
    PH_BEGIN(1) GEMM_B(0, A, ws + WS_W1, N1P, D, RAW1, nullptr, N1P, nullptr);
        if (G > 64 && (int)blockIdx.x >= 64) {
            LAS float* scr = (LAS float*)(lds + wave * 16384);
            const float* fn1 = (const float*)ap->in[22] + D; bf16_t* wgu1 = (bf16_t*)(ws + WS_WGU1);
            const int gw1 = ((int)blockIdx.x - 64) * 8 + wave, NGW1 = (G - 64) * 8;
            conv_matrix<1>((const float*)ap->in[23] + (size_t)D * FF, D, FF, fn1, wgu1, 2 * FF, 0, gw1, NGW1, scr, lane);
            conv_matrix<1>((const float*)ap->in[24] + (size_t)D * FF, D, FF, fn1, wgu1, 2 * FF, 1, gw1, NGW1, scr, lane);
            { const int n4 = 2 * M * PLE / 4; const f32x4* p4 = (const f32x4*)pin; u32x2* o2 = (u32x2*)PBF;
              for (int i = ((int)blockIdx.x - 64) * 512 + tid; i < n4; i += (G - 64) * 512) { const f32x4 v = p4[i]; u32x2 w; w.x = cvt_pk_bf16(v.x, v.y); w.y = cvt_pk_bf16(v.z, v.w); o2[i] = w; } }
        }
    PH_END(1)
#if PROBE_DUP1
    PH_BEGIN(1) GEMM_B(0, A, ws + WS_W1, N1P, D, RAW1, nullptr, N1P, nullptr); PH_END(1)
#endif
    PH_BEGIN(2)
            for (int m0 = gw * 4; m0 < M; m0 += NGW * 4) {
                u32x4 v[4][2];
#pragma unroll
                for (int r = 0; r < 4; ++r)
#pragma unroll
                    for (int part = 0; part < 2; ++part) v[r][part] = *(const u32x4*)(RAW1 + (size_t)(m0 + r) * N1P + part * 512 + lane * 8);
#pragma unroll
                for (int r = 0; r < 4; ++r)
#pragma unroll
                    for (int part = 0; part < 2; ++part) {
                        const u32x4 q = v[r][part];
                        const float f0 = bflo(q.x), f1 = bfhi(q.x), f2 = bflo(q.y), f3 = bfhi(q.y), f4 = bflo(q.z), f5 = bfhi(q.z), f6 = bflo(q.w), f7 = bfhi(q.w);
                        const float sq = (f0 * f0 + f1 * f1) + (f2 * f2 + f3 * f3) + (f4 * f4 + f5 * f5) + (f6 * f6 + f7 * f7);
                        const float rstd = __builtin_amdgcn_rsqf(wave_sum(sq) * (1.0f / 512) + EPS);
                        u32x4 w; w.x = cvt_pk_bf16(f0 * rstd, f1 * rstd); w.y = cvt_pk_bf16(f2 * rstd, f3 * rstd); w.z = cvt_pk_bf16(f4 * rstd, f5 * rstd); w.w = cvt_pk_bf16(f6 * rstd, f7 * rstd);
                        *(u32x4*)((part ? CKVN : CQN) + (size_t)(m0 + r) * 512 + lane * 8) = w;
                    }
            }
    PH_END(2)
    PH_BEGIN(3) GEMM_B(0, CQN, ws + WS_WUQ, 3072, 512, QA, nullptr, 3072, nullptr); GEMM_B(1, CKVN, ws + WS_WUKV, 4096, 512, KN, VA, 2048, nullptr); PH_END(3)
#if PROBE_DUP3
    PH_BEGIN(3) GEMM_B(0, CQN, ws + WS_WUQ, 3072, 512, QA, nullptr, 3072, nullptr); GEMM_B(1, CKVN, ws + WS_WUKV, 4096, 512, KN, VA, 2048, nullptr); PH_END(3)
#endif
    PH_BEGIN(4)
            const float* g_kn = (const float*)ap->in[11];
            const float gk0 = g_kn[lane], gk1 = g_kn[64 + lane], gk2 = g_kn[128 + lane];
            const float invf = exp2f(-(float)(lane & 31) * (13.287712379549449f / 32.0f));
            const float sgn = (lane < 32) ? -1.0f : 1.0f;
            float* CSt = (float*)(ws + WS_ROPE); float* SNt = CSt + (size_t)M * 32;
            for (int m = gw; m < M; m += NGW) {
                const bf16_t* knrow = KN + (size_t)m * 2048; bf16_t* krow = KA + (size_t)m * 3072;
                unsigned short ka[NH], kb[NH];
#pragma unroll
                for (int h = 0; h < NH; ++h) { ka[h] = knrow[h * 128 + lane]; kb[h] = knrow[h * 128 + 64 + lane]; }
                const float kpe = bf2f(RAW1[(size_t)m * N1P + 1024 + lane]);
                const float ang = (float)positions[m] * invf;
                const double red = (double)ang - 6.283185307179586 * rint((double)ang * 0.15915494309189535);
                const float cs = cosf((float)red), sn = sinf((float)red);
                if (lane < 32) { CSt[(size_t)m * 32 + lane] = cs; SNt[(size_t)m * 32 + lane] = sn; }
#pragma unroll
                for (int h = 0; h < NH; ++h) {
                    float a = bf2f(ka[h]), b = bf2f(kb[h]), c = kpe;
                    const float rstd = __builtin_amdgcn_rsqf(wave_sum(a * a + b * b + c * c) * (1.0f / 192) + EPS);
                    a *= rstd * gk0; b *= rstd * gk1; c *= rstd * gk2;
                    const float pr = __shfl_xor(c, 32); c = c * cs + sgn * pr * sn;
                    krow[h * 192 + lane] = (bf16_t)(cvt_pk_bf16(a, 0.f) & 0xffffu); krow[h * 192 + 64 + lane] = (bf16_t)(cvt_pk_bf16(b, 0.f) & 0xffffu); krow[h * 192 + 128 + lane] = (bf16_t)(cvt_pk_bf16(c, 0.f) & 0xffffu);
                }
            }
    PH_END(4)
    PH_BEGIN(5) { AttnP P{QA, 3072, 192, KA, 3072, 192, VA, 2048, 128, OA, 2048, nullptr, positions, (const float*)ap->in[10], (const float*)(ws + WS_ROPE), (const float*)(ws + WS_ROPE) + (size_t)M * 32}; for (int rep = 0; rep < REP_P5; ++rep) { if (rep) grid.sync(); attn_phase<192, false>(lds, P, tid); } } PH_END(5)
    PH_BEGIN(6) GEMM_R(0, 0, OA, ws + WS_WOA, D, x, nullptr, nullptr, nullptr, A, SS, nullptr, D, (size_t)128, 0); PH_END(6)
    PH_BEGIN(8) GEMM_B(2, A, ws + WS_WGU0, 2 * FF, D, HB, nullptr, FF, SS); PH_END(8)
#if PROBE_DUP8
    PH_BEGIN(8) GEMM_B(2, A, ws + WS_WGU0, 2 * FF, D, HB, nullptr, FF, SS); PH_END(8)
#endif
    PH_BEGIN(9) GEMM_R(0, 1, HB, ws + WS_WD0, FF, nullptr, A, nullptr, nullptr, A, SS + M, nullptr, 64, (size_t)M * 128, 0); GEMM_B(0, PBF, ws + WS_WEP0, D, PLE, PP, nullptr, D, nullptr); PH_END(9)
    PH_BEGIN(11) GEMM_R(1, 1, A, ws + WS_WEG0, D, nullptr, A, nullptr, PP, AB, SS + 2 * M, SS + M, D, (size_t)128, 0); PH_END(11)
    PH_BEGIN(13) GEMM_B(0, AB, ws + WS_WSKVQ, 6144, D, RAW3, nullptr, 6144, SS + 2 * M); PH_END(13)
#if PROBE_DUP13
    PH_BEGIN(13) GEMM_B(0, AB, ws + WS_WSKVQ, 6144, D, RAW3, nullptr, 6144, SS + 2 * M); PH_END(13)
#endif
    PH_BEGIN(14)
            const float* gk = (const float*)ap->in[16];
            const float gk0 = gk[2 * lane], gk1 = gk[2 * lane + 1];
            for (int m = gw; m < M; m += NGW) {
                unsigned* row = (unsigned*)(RAW3 + (size_t)m * 6144);
                unsigned kw[NH];
#pragma unroll
                for (int h = 0; h < NH; ++h) kw[h] = row[h * 64 + lane];
#pragma unroll
                for (int h = 0; h < NH; ++h) {
                    const float a = bflo(kw[h]), b = bfhi(kw[h]);
                    const float rstd = __builtin_amdgcn_rsqf(wave_sum(a * a + b * b) * (1.0f / 128) + EPS);
                    row[h * 64 + lane] = cvt_pk_bf16(a * rstd * gk0, b * rstd * gk1);
                }
            }
    PH_END(14)
    PH_BEGIN(15) { AttnP P{RAW3 + 4096, 6144, 128, RAW3, 6144, 128, RAW3 + 2048, 6144, 128, OB, 2048, (const float*)ap->in[20], positions, (const float*)ap->in[19], nullptr, nullptr}; for (int rep = 0; rep < REP_P15; ++rep) { if (rep) grid.sync(); attn_phase<128, true>(lds, P, tid); } }
        if ((G & 3) == 0 && ((int)blockIdx.x & 3) < 2) {
            __syncthreads();
            LAS float* scr = (LAS float*)(lds + wave * 16384);
            const int j3 = ((int)blockIdx.x >> 2) * 3, NGW1 = (G >> 2) * 3 * 8;
            if (((int)blockIdx.x & 3) == 0) { conv_matrix<0>((const float*)ap->in[25] + (size_t)FF * D, FF, D, nullptr, (bf16_t*)(ws + WS_WD1), D, 0, j3 * 8 + wave, NGW1, scr, lane);
                                              conv_matrix<0>((const float*)ap->in[25] + (size_t)FF * D, FF, D, nullptr, (bf16_t*)(ws + WS_WD1), D, 0, (j3 + 1) * 8 + wave, NGW1, scr, lane); }
            else conv_matrix<0>((const float*)ap->in[25] + (size_t)FF * D, FF, D, nullptr, (bf16_t*)(ws + WS_WD1), D, 0, (j3 + 2) * 8 + wave, NGW1, scr, lane);
        }
    PH_END(15)
    PH_BEGIN(16) GEMM_R(0, 1, OB, ws + WS_WOB, D, nullptr, AB, nullptr, nullptr, A, SS + 3 * M, nullptr, D, (size_t)128, 0); PH_END(16)
    PH_BEGIN(18) GEMM_B(2, A, ws + WS_WGU1, 2 * FF, D, HB, nullptr, FF, SS + 3 * M); PH_END(18)
    PH_BEGIN(19) GEMM_R(0, 1, HB, ws + WS_WD1, FF, nullptr, A, nullptr, nullptr, A, SS + 4 * M, nullptr, 64, (size_t)M * 128, 0); GEMM_B(0, PBF + (size_t)M * PLE, ws + WS_WEP1, D, PLE, PP, nullptr, D, nullptr); PH_END(19)
    PH_BEGIN(21) GEMM_R(1, 1, A, ws + WS_WEG1, D, nullptr, A, out, PP, nullptr, nullptr, SS + 4 * M, D, (size_t)128, 0); PH_END(21)
}

extern "C" void kernel_launch(void* const* d_in, const int* in_sizes, int n_in, void* d_out, int out_size, void* d_ws, size_t ws_size, hipStream_t stream) {
    static int grid = 0;
    if (grid == 0) {
        if (n_in != 29 || out_size != M * D || ws_size < WS_END) { fprintf(stderr, "kernel_launch: unexpected shapes (n_in %d out %d ws %zu)\n", n_in, out_size, ws_size); grid = -1; return; }
        int dev = 0, cus = 0, per_cu = 0;
        hipGetDevice(&dev); hipDeviceGetAttribute(&cus, hipDeviceAttributeMultiprocessorCount, dev);
        hipFuncSetAttribute((const void*)yoco_fwd, hipFuncAttributeMaxDynamicSharedMemorySize, LDS_BYTES);
        hipOccupancyMaxActiveBlocksPerMultiprocessor(&per_cu, (const void*)yoco_fwd, 512, LDS_BYTES);
        if (per_cu < 1) per_cu = 1;
        grid = cus * per_cu;
        (void)hipGetLastError();
    }
    if (grid < 0) return;
    if (hipMemsetAsync((char*)d_ws + WS_BAR, 0, XCD_BAR_WORDS * 4, stream) != hipSuccess) { fprintf(stderr, "kernel_launch: hipMemsetAsync failed\n"); return; }
    Args a{};
    for (int i = 0; i < 29; ++i) a.in[i] = d_in[i];
    a.out = (float*)d_out; a.ws = (unsigned char*)d_ws; a.ph_lo = 0; a.ph_hi = NPHASE;
    void* kargs[] = {&a};
    hipError_t e = hipLaunchCooperativeKernel((const void*)yoco_fwd, dim3(grid), dim3(512), kargs, LDS_BYTES, stream);
    if (e != hipSuccess) fprintf(stderr, "cooperative launch failed: %s (grid %d)\n", hipGetErrorString(e), grid);
}
```
